# Optimizing an MI355X kernel written in HIP

```python
import jax, jax.numpy as jnp
from jax import lax
import numpy as np

D_MODEL = 1024
BATCH = 8
SEQ = 2048
DEPTH = 1
DEC_BATCH = 128
DEC_SEQ = 8
PAST_LEN = 16384
PAGE_SIZE = 128

CONV_WIDTH = 3
CONV_DIM = D_MODEL
GLA_HEADS = 4
GLA_DK = D_MODEL // 2 // GLA_HEADS
GLA_DV = D_MODEL // GLA_HEADS
GLA_RANK = 16
GLA_TAU = 16.0
GLA_CHUNK = 16
D_FF = 2816
EPS = 1e-6
IN_SIZES = (CONV_DIM, CONV_DIM, CONV_DIM,
            GLA_HEADS * GLA_DK, GLA_HEADS * GLA_DK, GLA_HEADS * GLA_DV, GLA_HEADS * GLA_DV, GLA_RANK,
            D_MODEL, D_MODEL)
IN_COLS = sum(IN_SIZES)

kernel_name = "hybrid_conv_gla_convffn_step"


def rmsnorm(x, g):
    x32 = x.astype(jnp.float32)
    y = x32 * lax.rsqrt(jnp.mean(x32 * x32, axis=-1, keepdims=True) + EPS)
    return (y * g.astype(jnp.float32)).astype(x.dtype)


def causal_dwconv(u, buf, w, b):
    T = u.shape[1]
    ext = jnp.concatenate([buf.astype(u.dtype), u], axis=1)
    y = b + sum(w[j] * ext[:, j:j + T] for j in range(CONV_WIDTH))
    return y, ext[:, -(CONV_WIDTH - 1):]


def gla_recurrence(q, k, v, log_a, s0):
    B, T = q.shape[:2]
    L = GLA_CHUNK
    n = -(-T // L)
    pad = n * L - T

    def prep(t):
        t = jnp.pad(t, ((0, 0), (0, pad), (0, 0), (0, 0)))
        return t.reshape(B, n, L, t.shape[2], t.shape[3]).transpose(1, 0, 3, 2, 4)

    qc, kc, vc, ac = prep(q), prep(k), prep(v), prep(log_a)
    mask = jnp.tril(jnp.ones((L, L), dtype=bool))[None, None, :, :, None]

    def step(S, inp):
        qi, ki, vi, ai = inp
        qi = qi.astype(jnp.float32); ki = ki.astype(jnp.float32); vi = vi.astype(jnp.float32)
        bcum = jnp.cumsum(ai.astype(jnp.float32), axis=2)
        diff = bcum[:, :, :, None, :] - bcum[:, :, None, :, :]
        decay = jnp.exp(jnp.where(mask, diff, -jnp.inf))
        scores = jnp.einsum('bhtd,bhsd,bhtsd->bhts', qi, ki, decay)
        intra = jnp.einsum('bhts,bhsv->bhtv', scores, vi)
        inter = jnp.einsum('bhtd,bhdv->bhtv', qi * jnp.exp(bcum), S)
        b_last = bcum[:, :, -1:, :]
        S_new = jnp.exp(b_last[:, :, 0, :])[..., None] * S + jnp.einsum(
            'bhsd,bhsv->bhdv', ki * jnp.exp(b_last - bcum), vi)
        return S_new, intra + inter

    S_fin, o = lax.scan(step, s0.astype(jnp.float32), (qc, kc, vc, ac))
    o = o.transpose(1, 0, 3, 2, 4).reshape(B, n * L, GLA_HEADS, GLA_DV)[:, :T]
    return o, S_fin


def layer(x, c, conv_buf, gla_state, ffn_buf,
          w_ada, b_ada, norm_pre1, norm_post1, norm_pre2, norm_post2,
          w_in, conv_w, conv_b, w_a2, b_a, gla_norm, w_out,
          w_up, ffn_conv_w, ffn_conv_b, w_down):
    Bn, T = x.shape[:2]
    mod = jax.nn.silu(c) @ w_ada + b_ada
    sh1, sc1, g1, sh2, sc2, g2 = jnp.split(mod, 6, axis=-1)

    h = rmsnorm(x, norm_pre1) * (1 + sc1[:, None]) + sh1[:, None]
    proj = h @ w_in
    split_idx = [int(s) for s in np.cumsum(IN_SIZES)[:-1]]
    bg, cg, ua, q, k, v, r, lr, ga, gb = jnp.split(proj, split_idx, axis=-1)

    conv_out, conv_buf_new = causal_dwconv(cg * ua, conv_buf, conv_w, conv_b)
    y_a = bg * conv_out

    q = q.reshape(Bn, T, GLA_HEADS, GLA_DK) * (GLA_DK ** -0.5)
    k = k.reshape(Bn, T, GLA_HEADS, GLA_DK)
    v = v.reshape(Bn, T, GLA_HEADS, GLA_DV)
    log_a = jax.nn.log_sigmoid((lr @ w_a2 + b_a).astype(jnp.float32)) / GLA_TAU
    log_a = log_a.reshape(Bn, T, GLA_HEADS, GLA_DK)
    o, gla_state_new = gla_recurrence(q, k, v, log_a, gla_state)
    o = rmsnorm(o.astype(x.dtype), gla_norm)
    y_b = o.reshape(Bn, T, GLA_HEADS * GLA_DV) * jax.nn.silu(r)

    merged = jax.nn.sigmoid(ga) * y_a + jax.nn.sigmoid(gb) * y_b
    x = x + g1[:, None] * rmsnorm(merged @ w_out, norm_post1)

    h2 = rmsnorm(x, norm_pre2) * (1 + sc2[:, None]) + sh2[:, None]
    a, gt = jnp.split(h2 @ w_up, 2, axis=-1)
    a_conv, ffn_buf_new = causal_dwconv(a, ffn_buf, ffn_conv_w, ffn_conv_b)
    f = (jax.nn.gelu(a_conv) * gt) @ w_down
    x = x + g2[:, None] * rmsnorm(f, norm_post2)
    return x, conv_buf_new, gla_state_new.astype(gla_state.dtype), ffn_buf_new


def setup_inputs(seed: int = 0) -> dict:
    key = jax.random.key(seed)
    ks = jax.random.split(key, 32)
    nrm = jax.random.normal
    f32 = jnp.float32
    d = D_MODEL
    hk = GLA_HEADS * GLA_DK
    return {
        "x_prompt": nrm(ks[0], (BATCH, SEQ, d), f32),
        "x_sample": nrm(ks[1], (DEC_BATCH, DEC_SEQ, d), f32),
        "c_prompt": nrm(ks[2], (BATCH, d), f32),
        "c_sample": nrm(ks[3], (DEC_BATCH, d), f32),
        "state_conv_mix": nrm(ks[4], (DEPTH, DEC_BATCH, CONV_WIDTH - 1, CONV_DIM), f32),
        "state_gla": 0.3 * nrm(ks[5], (DEPTH, DEC_BATCH, GLA_HEADS, GLA_DK, GLA_DV), f32),
        "state_conv_ffn": nrm(ks[6], (DEPTH, DEC_BATCH, CONV_WIDTH - 1, D_FF), f32),
        "w_ada": 0.5 * d ** -0.5 * nrm(ks[7], (DEPTH, d, 6 * d), f32),
        "b_ada": 0.01 * nrm(ks[8], (DEPTH, 6 * d), f32),
        "norm_pre1": 1.0 + 0.1 * nrm(ks[9], (DEPTH, d), f32),
        "norm_post1": 1.0 + 0.1 * nrm(ks[10], (DEPTH, d), f32),
        "norm_pre2": 1.0 + 0.1 * nrm(ks[11], (DEPTH, d), f32),
        "norm_post2": 1.0 + 0.1 * nrm(ks[12], (DEPTH, d), f32),
        "w_in": d ** -0.5 * nrm(ks[13], (DEPTH, d, IN_COLS), f32),
        "conv_w": CONV_WIDTH ** -0.5 * nrm(ks[14], (DEPTH, CONV_WIDTH, CONV_DIM), f32),
        "conv_b": 0.01 * nrm(ks[15], (DEPTH, CONV_DIM), f32),
        "w_a2": GLA_RANK ** -0.5 * nrm(ks[16], (DEPTH, GLA_RANK, hk), f32),
        "b_a": 0.1 * nrm(ks[17], (DEPTH, hk), f32),
        "gla_norm": 1.0 + 0.1 * nrm(ks[18], (DEPTH, GLA_HEADS, GLA_DV), f32),
        "w_out": d ** -0.5 * nrm(ks[19], (DEPTH, d, d), f32),
        "w_up": d ** -0.5 * nrm(ks[20], (DEPTH, d, 2 * D_FF), f32),
        "ffn_conv_w": CONV_WIDTH ** -0.5 * nrm(ks[21], (DEPTH, CONV_WIDTH, D_FF), f32),
        "ffn_conv_b": 0.01 * nrm(ks[22], (DEPTH, D_FF), f32),
        "w_down": D_FF ** -0.5 * nrm(ks[23], (DEPTH, D_FF, d), f32),
    }


def reference(x_prompt, x_sample, c_prompt, c_sample, state_conv_mix, state_gla, state_conv_ffn,
              w_ada, b_ada, norm_pre1, norm_post1, norm_pre2, norm_post2,
              w_in, conv_w, conv_b, w_a2, b_a, gla_norm, w_out,
              w_up, ffn_conv_w, ffn_conv_b, w_down):
    xp, xs = x_prompt, x_sample
    pc, pg, pf, sc, sg, sf = [], [], [], [], [], []
    for l in range(DEPTH):
        weights = (w_ada[l], b_ada[l], norm_pre1[l], norm_post1[l], norm_pre2[l], norm_post2[l],
                   w_in[l], conv_w[l], conv_b[l], w_a2[l], b_a[l], gla_norm[l], w_out[l],
                   w_up[l], ffn_conv_w[l], ffn_conv_b[l], w_down[l])
        zc = jnp.zeros((xp.shape[0], CONV_WIDTH - 1, CONV_DIM), xp.dtype)
        zg = jnp.zeros((xp.shape[0], GLA_HEADS, GLA_DK, GLA_DV), state_gla.dtype)
        zf = jnp.zeros((xp.shape[0], CONV_WIDTH - 1, D_FF), xp.dtype)
        xp, c1, g1, f1 = layer(xp, c_prompt, zc, zg, zf, *weights)
        xs, c2, g2, f2 = layer(xs, c_sample, state_conv_mix[l], state_gla[l], state_conv_ffn[l], *weights)
        pc.append(c1); pg.append(g1); pf.append(f1)
        sc.append(c2); sg.append(g2); sf.append(f2)
    return (xp, xs,
            jnp.stack(pc), jnp.stack(pg), jnp.stack(pf),
            jnp.stack(sc), jnp.stack(sg), jnp.stack(sf))
```

```cpp
#include <hip/hip_runtime.h>
#include <cstdio>
#include <cstdint>
namespace pg8 {
#define PG8_LAS __attribute__((address_space(3)))
typedef unsigned short bf16_t;
typedef short bf16x8 __attribute__((ext_vector_type(8)));
typedef float f32x4 __attribute__((ext_vector_type(4)));
typedef unsigned u32x4 __attribute__((ext_vector_type(4)));
constexpr int BM = 256, BK = 64, HALF = 128, HTB = HALF * BK * 2  , STAGE_BYTES = 8 * HTB, NXCD = 8, WGM = 8;

__host__ __device__ __forceinline__ int lds_byte(int r, int c) { const int st = (r >> 4) * 2 + (c >> 5), rr = r & 15, cc = c & 31, ob = rr * 64 + cc * 2; return st * 1024 + (ob ^ (((ob >> 9) & 1) << 5)); }
__host__ __device__ __forceinline__ void stage_rc(int b, int& R, int& C) { const int st = b / 1024, sb = b % 1024, swz = sb ^ (((sb >> 9) & 1) << 5); R = (st >> 1) * 16 + swz / 64; C = (st & 1) * 32 + (swz % 64) / 2; }
__host__ __device__ __forceinline__ int perm32(int rho) { const int n = rho >> 4, i = rho & 15; return 8 * (i >> 2) + 4 * n + (i & 3); }

struct Unit { int pm, pn; };
struct Gemm { const bf16_t* A; const bf16_t* Bt; int M, N, K; };

struct StaticOrder {
    int nM, nN, nwg, G, c;
    __host__ __device__ void init(int M, int N, int G_, int c_) { nM = M / BM; nN = N / BM; nwg = nM * nN; G = G_; c = c_; }
    __host__ __device__ bool next(int i, Unit& u) const {
        const long L = (long)i * G + c; if (L >= nwg) return false;
        int wgid = (int)L; { const int q = nwg / NXCD, r = nwg % NXCD, xcd = wgid % NXCD, off = wgid / NXCD; wgid = (xcd < r ? xcd * (q + 1) : r * (q + 1) + (xcd - r) * q) + off; }
        const int nig = WGM * nN, gid = wgid / nig, fm = gid * WGM, gsz = (nM - fm) < WGM ? (nM - fm) : WGM;
        u.pm = fm + ((wgid % nig) % gsz); u.pn = (wgid % nig) / gsz; return true;
    }
    __device__ __forceinline__ void a_ready(const Unit&) const {}
    __device__ __forceinline__ void done(const Unit&) const {}
};

typedef float f32x2 __attribute__((ext_vector_type(2)));
typedef __bf16 bf16x2v __attribute__((ext_vector_type(2)));
__device__ __forceinline__ unsigned cvt_pk_bf16(float lo, float hi) { f32x2 v = {lo, hi}; bf16x2v b = __builtin_convertvector(v, bf16x2v); return __builtin_bit_cast(unsigned, b); }
__device__ __forceinline__ float sigmoidf_fast(float y) { return __builtin_amdgcn_rcpf(1.0f + __builtin_amdgcn_exp2f(-1.4426950408889634f * y)); }

struct EpiF32 {
    static constexpr bool PERM = false, AFTER_DRAIN = false;
    float* C; int ldc;
    __device__ __forceinline__ void operator()(const f32x4 (&acc)[2][2][4][2], const Unit& u, int wr, int wc, int fr, int fq) const {
        const int row0 = u.pm * BM + wr * 64 + fr, col0 = u.pn * BM + wc * 32 + 4 * fq;
#pragma unroll
        for (int ai = 0; ai < 2; ++ai)
#pragma unroll
            for (int m = 0; m < 4; ++m) { float* rowp = C + (size_t)(row0 + ai * HALF + m * 16) * ldc + col0;
#pragma unroll
                for (int bj = 0; bj < 2; ++bj)
#pragma unroll
                    for (int n = 0; n < 2; ++n) *(f32x4*)(rowp + bj * HALF + n * 16) = acc[ai][bj][m][n]; }
    }
};

struct EpiProj {
    static constexpr bool PERM = true, AFTER_DRAIN = false;
    bf16_t* P; size_t S;
    __device__ __forceinline__ void operator()(const f32x4 (&acc)[2][2][4][2], const Unit& u, int wr, int wc, int fr, int fq) const {
        const int row0 = u.pm * BM + wr * 64 + fr, cl = wc * 32 + 8 * fq, pn = u.pn;
        if (pn < 24) {
            const int type = pn >> 3; bf16_t* base = P + (size_t)type * S + 128 * (pn & 7) + cl;
#pragma unroll
            for (int ai = 0; ai < 2; ++ai)
#pragma unroll
                for (int m = 0; m < 4; ++m) {
                    const f32x4 x0 = acc[ai][0][m][0], x1 = acc[ai][0][m][1], y0 = acc[ai][1][m][0], y1 = acc[ai][1][m][1];
                    f32x4 o0, o1;
                    if (type == 0) { o0 = x0 * y0; o1 = x1 * y1; }
                    else {
                        f32x4 s0, s1;
#pragma unroll
                        for (int i = 0; i < 4; ++i) { s0[i] = sigmoidf_fast(y0[i]); s1[i] = sigmoidf_fast(y1[i]); }
                        o0 = x0 * s0; o1 = x1 * s1;
                        if (type == 2) {
#pragma unroll
                            for (int i = 0; i < 4; ++i) { s0[i] = sigmoidf_fast(x0[i]); s1[i] = sigmoidf_fast(x1[i]); }
                            o0 = o0 * s0; o1 = o1 * s1;
                        }
                    }
                    u32x4 w; w.x = cvt_pk_bf16(o0[0], o0[1]); w.y = cvt_pk_bf16(o0[2], o0[3]); w.z = cvt_pk_bf16(o1[0], o1[1]); w.w = cvt_pk_bf16(o1[2], o1[3]);
                    *(u32x4*)(base + (size_t)(row0 + ai * HALF + m * 16) * 1024) = w;
                }
        } else if (pn < 32) {
            bf16_t* base = (pn < 28 ? P + 3 * S + 256 * (pn - 24) : P + 4 * S + 256 * (pn - 28)) + cl;
#pragma unroll
            for (int ai = 0; ai < 2; ++ai)
#pragma unroll
                for (int m = 0; m < 4; ++m)
#pragma unroll
                    for (int bj = 0; bj < 2; ++bj) { const f32x4 v0 = acc[ai][bj][m][0], v1 = acc[ai][bj][m][1];
                        u32x4 w; w.x = cvt_pk_bf16(v0[0], v0[1]); w.y = cvt_pk_bf16(v0[2], v0[3]); w.z = cvt_pk_bf16(v1[0], v1[1]); w.w = cvt_pk_bf16(v1[2], v1[3]);
                        *(u32x4*)(base + (size_t)(row0 + ai * HALF + m * 16) * 1024 + bj * HALF) = w; }
        } else {
            if (wc == 0 && fq < 2) {
#pragma unroll
                for (int ai = 0; ai < 2; ++ai)
#pragma unroll
                    for (int m = 0; m < 4; ++m) { const f32x4 v0 = acc[ai][0][m][0], v1 = acc[ai][0][m][1];
                        u32x4 w; w.x = cvt_pk_bf16(v0[0], v0[1]); w.y = cvt_pk_bf16(v0[2], v0[3]); w.z = cvt_pk_bf16(v1[0], v1[1]); w.w = cvt_pk_bf16(v1[2], v1[3]);
                        *(u32x4*)(P + 5 * S + (size_t)(row0 + ai * HALF + m * 16) * 16 + 8 * fq) = w; }
            }
        }
    }
};

struct EpiUp {
    static constexpr bool PERM = true, AFTER_DRAIN = false;
    bf16_t *A, *G; int ldc;
    __device__ __forceinline__ void operator()(const f32x4 (&acc)[2][2][4][2], const Unit& u, int wr, int wc, int fr, int fq) const {
        const int row0 = u.pm * BM + wr * 64 + fr, col = 128 * u.pn + wc * 32 + 8 * fq;
#pragma unroll
        for (int ai = 0; ai < 2; ++ai)
#pragma unroll
            for (int m = 0; m < 4; ++m)
#pragma unroll
                for (int bj = 0; bj < 2; ++bj) { const f32x4 v0 = acc[ai][bj][m][0], v1 = acc[ai][bj][m][1];
                    u32x4 w; w.x = cvt_pk_bf16(v0[0], v0[1]); w.y = cvt_pk_bf16(v0[2], v0[3]); w.z = cvt_pk_bf16(v1[0], v1[1]); w.w = cvt_pk_bf16(v1[2], v1[3]);
                    *(u32x4*)((bj == 0 ? A : G) + (size_t)(row0 + ai * HALF + m * 16) * ldc + col) = w; }
    }
};

template <class Epi, class Sched, bool ALIGN_EPI = false, bool SP2 = false>
__device__ __forceinline__ void gemm_phase(PG8_LAS unsigned char* lds, const Gemm g, const Sched& S, const Epi& E) {
    const int tid = threadIdx.x, wid = __builtin_amdgcn_readfirstlane(tid >> 6), lane = tid & 63, wr = wid >> 2, wc = wid & 3, fr = lane & 15, fq = lane >> 4;
    const int K = g.K, nt = K / BK;
    unsigned voffA[2], voffB[2];
#pragma unroll
    for (int i = 0; i < 2; ++i) { int R, C; stage_rc(tid * 16 + i * 8192, R, C); const int Rb = Epi::PERM ? ((R & ~31) + perm32(R & 31)) : R;
        voffA[i] = (unsigned)(R * K + C) * 2u; voffB[i] = (unsigned)(Rb * K + C) * 2u; }
    const size_t kstep = (size_t)(BK * 2);
    const size_t hstep = (size_t)HALF * K * 2;
    const size_t tstep = 2 * hstep;
    const unsigned ldsw = (unsigned)wid * 1024u;
    const int aoff = lds_byte(wr * 64 + fr, fq * 8), boff = lds_byte(wc * 32 + fr, fq * 8);
#define PG8_SA(b, h) (((b) * 2 + (h)) * HTB)
#define PG8_SB(b, h) ((4 + (b) * 2 + (h)) * HTB)
#define PG8_STAGE(bufoff, gbase, voff) do { _Pragma("unroll") for (int _i = 0; _i < 2; ++_i) \
        __builtin_amdgcn_global_load_lds((const unsigned*)((const char*)(gbase) + (voff)[_i]), (PG8_LAS unsigned*)(lds + (bufoff) + ldsw + _i * 8192), 16, 0, 0); } while (0)
#define PG8_LDA(dst, b, h) do { _Pragma("unroll") for (int m = 0; m < 4; ++m) _Pragma("unroll") for (int k = 0; k < 2; ++k) dst[m][k] = *(const PG8_LAS bf16x8*)(lds + PG8_SA(b, h) + aoff + m * 2048 + k * 1024); } while (0)
#define PG8_LDB(dst, b, h) do { _Pragma("unroll") for (int n = 0; n < 2; ++n) _Pragma("unroll") for (int k = 0; k < 2; ++k) dst[n][k] = *(const PG8_LAS bf16x8*)(lds + PG8_SB(b, h) + boff + n * 2048 + k * 1024); } while (0)
#define PG8_MMA(ai, bj, At, Bt) do { __builtin_amdgcn_s_setprio(1); _Pragma("unroll") for (int m = 0; m < 4; ++m) _Pragma("unroll") for (int n = 0; n < 2; ++n) _Pragma("unroll") for (int k = 0; k < 2; ++k) \
        acc[ai][bj][m][n] = __builtin_amdgcn_mfma_f32_16x16x32_bf16(Bt[n][k], At[m][k], acc[ai][bj][m][n], 0, 0, 0); __builtin_amdgcn_s_setprio(0); } while (0)
#define PG8_WAIT_V(n) asm volatile("s_waitcnt vmcnt(" #n ")" ::: "memory")
#define PG8_WAIT_L(n) asm volatile("s_waitcnt lgkmcnt(" #n ")" ::: "memory")
#define PG8_BAR __builtin_amdgcn_s_barrier()
#define PG8_SCHED __builtin_amdgcn_sched_barrier(0)
    Unit cur, nxt; int ui = 0;
    if (!S.next(0, cur)) return;
    f32x4 acc[2][2][4][2];
#pragma unroll
    for (int a = 0; a < 2; ++a)
#pragma unroll
        for (int b = 0; b < 2; ++b)
#pragma unroll
            for (int m = 0; m < 4; ++m)
#pragma unroll
                for (int n = 0; n < 2; ++n) acc[a][b][m][n] = (f32x4){0.f, 0.f, 0.f, 0.f};
    bf16x8 At[4][2], B0[2][2], B1[2][2];
    const char* cA = (const char*)g.A + (size_t)cur.pm * tstep; const char* cB = (const char*)g.Bt + (size_t)cur.pn * tstep;
    S.a_ready(cur);
    if constexpr (SP2) {
        PG8_STAGE(PG8_SB(0, 0), cB, voffB); PG8_STAGE(PG8_SB(0, 1), cB + hstep, voffB); PG8_STAGE(PG8_SA(0, 0), cA, voffA); PG8_STAGE(PG8_SA(0, 1), cA + hstep, voffA);
        if (wr == 1) PG8_BAR;
        PG8_WAIT_V(2); PG8_BAR;
        PG8_STAGE(PG8_SB(1, 0), cB + kstep, voffB); PG8_STAGE(PG8_SA(1, 0), cA + kstep, voffA); PG8_STAGE(PG8_SB(1, 1), cB + hstep + kstep, voffB);
        PG8_WAIT_V(6); PG8_BAR;
    } else {
        PG8_STAGE(PG8_SB(0, 0), cB, voffB); PG8_STAGE(PG8_SA(0, 0), cA, voffA); PG8_STAGE(PG8_SB(0, 1), cB + hstep, voffB); PG8_STAGE(PG8_SA(0, 1), cA + hstep, voffA);
        if (wr == 1) PG8_BAR;
        PG8_WAIT_V(4); PG8_BAR;
        PG8_STAGE(PG8_SB(1, 0), cB + kstep, voffB); PG8_STAGE(PG8_SA(1, 0), cA + kstep, voffA); PG8_STAGE(PG8_SB(1, 1), cB + hstep + kstep, voffB);
        PG8_WAIT_V(6); PG8_BAR;
    }
    for (;;) {
        const bool has_next = S.next(ui + 1, nxt);
        const char* nA = has_next ? (const char*)g.A + (size_t)nxt.pm * tstep : cA; const char* nB = has_next ? (const char*)g.Bt + (size_t)nxt.pn * tstep : cB;
        for (int t = 0; t < nt; t += 2) {
            const bool last = (t == nt - 2);
            const char* a1 = cA + (size_t)(t + 1) * kstep;
            const char* a2 = last ? nA : cA + (size_t)(t + 2) * kstep; const char* b2 = last ? nB : cB + (size_t)(t + 2) * kstep;
            const char* a3 = a2 + kstep; const char* b3 = b2 + kstep;
            if (last && has_next) S.a_ready(nxt);
            if constexpr (SP2) {
            PG8_LDB(B0, 0, 0); PG8_LDB(B1, 0, 1); PG8_SCHED; PG8_LDA(At, 0, 0); PG8_STAGE(PG8_SA(1, 1), a1 + hstep, voffA);
            PG8_WAIT_V(8); PG8_WAIT_L(0); PG8_BAR; PG8_MMA(0, 0, At, B0); PG8_MMA(0, 1, At, B1); PG8_BAR; PG8_SCHED;
            PG8_LDA(At, 0, 1); PG8_STAGE(PG8_SB(0, 0), b2, voffB); PG8_STAGE(PG8_SB(0, 1), b2 + hstep, voffB); PG8_STAGE(PG8_SA(0, 0), a2, voffA);
            PG8_WAIT_V(8); PG8_WAIT_L(0); PG8_BAR; PG8_MMA(1, 0, At, B0); PG8_MMA(1, 1, At, B1); PG8_BAR; PG8_SCHED;
            PG8_LDB(B0, 1, 0); PG8_LDB(B1, 1, 1); PG8_SCHED; PG8_LDA(At, 1, 0); PG8_STAGE(PG8_SA(0, 1), a2 + hstep, voffA);
            PG8_WAIT_V(8); PG8_WAIT_L(0); PG8_BAR; PG8_MMA(0, 0, At, B0); PG8_MMA(0, 1, At, B1); PG8_BAR; PG8_SCHED;
            PG8_LDA(At, 1, 1); PG8_STAGE(PG8_SB(1, 0), b3, voffB); PG8_STAGE(PG8_SB(1, 1), b3 + hstep, voffB); PG8_STAGE(PG8_SA(1, 0), a3, voffA);
            PG8_WAIT_V(8); PG8_WAIT_L(0); PG8_BAR; PG8_MMA(1, 0, At, B0); PG8_MMA(1, 1, At, B1); PG8_BAR; PG8_SCHED;
            } else {
            PG8_LDB(B0, 0, 0); PG8_SCHED; PG8_LDA(At, 0, 0); PG8_STAGE(PG8_SA(1, 1), a1 + hstep, voffA);
            PG8_WAIT_L(8); PG8_BAR; PG8_WAIT_L(0); PG8_MMA(0, 0, At, B0); PG8_BAR; PG8_SCHED;
            PG8_LDB(B1, 0, 1); PG8_STAGE(PG8_SB(0, 0), b2, voffB);
            PG8_BAR; PG8_WAIT_L(0); PG8_MMA(0, 1, At, B1); PG8_BAR;
            PG8_LDA(At, 0, 1); PG8_STAGE(PG8_SA(0, 0), a2, voffA);
            PG8_BAR; PG8_WAIT_L(0); PG8_MMA(1, 0, At, B0); PG8_BAR; PG8_SCHED;
            PG8_STAGE(PG8_SB(0, 1), b2 + hstep, voffB);
            PG8_WAIT_V(6); PG8_BAR; PG8_MMA(1, 1, At, B1); PG8_BAR;
            PG8_LDB(B0, 1, 0); PG8_SCHED; PG8_LDA(At, 1, 0); PG8_STAGE(PG8_SA(0, 1), a2 + hstep, voffA);
            PG8_WAIT_L(8); PG8_BAR; PG8_WAIT_L(0); PG8_MMA(0, 0, At, B0); PG8_BAR; PG8_SCHED;
            PG8_LDB(B1, 1, 1); PG8_STAGE(PG8_SB(1, 0), b3, voffB);
            PG8_BAR; PG8_WAIT_L(0); PG8_MMA(0, 1, At, B1); PG8_BAR;
            PG8_LDA(At, 1, 1); PG8_STAGE(PG8_SA(1, 0), a3, voffA);
            PG8_BAR; PG8_WAIT_L(0); PG8_MMA(1, 0, At, B0); PG8_BAR; PG8_SCHED;
            PG8_STAGE(PG8_SB(1, 1), b3 + hstep, voffB);
            PG8_WAIT_V(6); PG8_BAR; PG8_MMA(1, 1, At, B1); PG8_BAR;
            }
        }
        if constexpr (ALIGN_EPI) { if (wr == 0) PG8_BAR; }
        if constexpr (!Epi::AFTER_DRAIN) { E(acc, cur, wr, wc, fr, fq); S.done(cur); }
        if (!has_next) break;
#pragma unroll
        for (int a = 0; a < 2; ++a)
#pragma unroll
            for (int b = 0; b < 2; ++b)
#pragma unroll
                for (int m = 0; m < 4; ++m)
#pragma unroll
                    for (int n = 0; n < 2; ++n) acc[a][b][m][n] = (f32x4){0.f, 0.f, 0.f, 0.f};
        cur = nxt; cA = nA; cB = nB; ++ui;
        if constexpr (ALIGN_EPI) { if (wr == 1) PG8_BAR; }
    }
    PG8_WAIT_V(0);
    if constexpr (!ALIGN_EPI) { if (wr == 0) PG8_BAR; }
    PG8_BAR;
    if constexpr (Epi::AFTER_DRAIN) { E.fused(acc, cur, wr, wc, fr, fq, lds, wid, lane); S.done(cur); }
#undef PG8_SA
#undef PG8_SB
#undef PG8_STAGE
#undef PG8_LDA
#undef PG8_LDB
#undef PG8_MMA
#undef PG8_WAIT_V
#undef PG8_WAIT_L
#undef PG8_BAR
#undef PG8_SCHED
}
}
#define GAS __attribute__((address_space(1)))
#define LAS __attribute__((address_space(3)))
typedef unsigned short bf16;
typedef unsigned v4u __attribute__((ext_vector_type(4)));
typedef float f32x4 __attribute__((ext_vector_type(4)));
typedef short bf16x8 __attribute__((ext_vector_type(8)));
typedef GAS unsigned gu32;
typedef GAS unsigned long long gu64;
#define RLX_AGENT __ATOMIC_RELAXED, __HIP_MEMORY_SCOPE_AGENT
#define LDS_WAIT() asm volatile("s_waitcnt lgkmcnt(0)" ::: "memory")
#define VM_WAIT() asm volatile("s_waitcnt vmcnt(0)" ::: "memory")
__device__ __forceinline__ unsigned long long rt() { return __builtin_amdgcn_s_memrealtime(); }
__device__ __forceinline__ unsigned f2bf(float f) { unsigned u = __builtin_bit_cast(unsigned, f); return (u + 0x7fffu + ((u >> 16) & 1u)) >> 16; }
__device__ __forceinline__ unsigned pk2(float lo, float hi) { return f2bf(lo) | (f2bf(hi) << 16); }

#define XB_TMO      128
#define XB_XCNT(j)  (256  + 64 * (j))
#define XB_XSUB(j)  (1280 + 64 * (j))
#define XB_XGEN(j)  (2304 + 64 * (j))
#define XB_TOP      3328
#define XB_TOPGEN   3392
#define XCD_BAR_WORDS 3456
#define XB_SPIN_CAP (1u << 18)

__device__ __forceinline__ unsigned xb_ld(unsigned* p)              { return __hip_atomic_load(p, __ATOMIC_RELAXED, __HIP_MEMORY_SCOPE_AGENT); }
__device__ __forceinline__ unsigned xb_add(unsigned* p, unsigned v) { return __hip_atomic_fetch_add(p, v, __ATOMIC_RELAXED, __HIP_MEMORY_SCOPE_AGENT); }
__device__ __forceinline__ unsigned xb_xcc_id() { return (unsigned)__builtin_amdgcn_s_getreg((3 << 11) | 20) & 0xFu; }
#define XB_SPIN(cond, bar) do { unsigned _sp = 0; while (cond) { __builtin_amdgcn_s_sleep(1); \
    if ((++_sp & 255u) == 0u) { if (xb_ld(&(bar)[XB_TMO])) break; if (_sp > XB_SPIN_CAP) { atomicAdd(&(bar)[XB_TMO], 1u); break; } } } } while (0)

struct XcdBarrier {
    unsigned* bar; unsigned x;
    volatile LAS unsigned* st;
};

__device__ __forceinline__ XcdBarrier xcd_barrier_post(unsigned* bar, volatile LAS unsigned* st) {
    XcdBarrier b; b.bar = bar; b.x = xb_xcc_id(); b.st = st;
    if (threadIdx.x == 0) (void)xb_add(&bar[XB_XCNT(b.x)], 1u);
    return b;
}
__device__ __forceinline__ void xcd_barrier_complete(unsigned* bar, unsigned x, unsigned& nloc, unsigned& nx) {
    const unsigned G = gridDim.x * gridDim.y * gridDim.z;
    unsigned sum, cnt, mine, sp = 0u;
    for (;;) {
        sum = 0u; cnt = 0u; mine = 0u;
#pragma unroll
        for (unsigned j = 0; j < 16; ++j) { const unsigned c = xb_ld(&bar[XB_XCNT(j)]); sum += c; cnt += (c > 0u) ? 1u : 0u; mine = (j == x) ? c : mine; }
        if (sum == G) break;
        __builtin_amdgcn_s_sleep(1);
        if ((++sp & 255u) == 0u) { if (xb_ld(&bar[XB_TMO])) break; if (sp > XB_SPIN_CAP) { atomicAdd(&bar[XB_TMO], 1u); break; } }
    }
    nloc = mine > 0u ? mine : 1u; nx = cnt > 0u ? cnt : 1u;
}

__device__ __forceinline__ void xcd_barrier(const XcdBarrier& b) {
    asm volatile("s_waitcnt vmcnt(0)" ::: "memory");
    __syncthreads();
    if (threadIdx.x == 0) {
        unsigned* bar = b.bar;
        __builtin_amdgcn_s_waitcnt(0);
        unsigned nloc = b.st[0], nx = b.st[1];
        if (nloc == 0u) { xcd_barrier_complete(bar, b.x, nloc, nx); b.st[0] = nloc; b.st[1] = nx; }
        const unsigned old = xb_add(&bar[XB_XSUB(b.x)], 1u);
        const unsigned gen = old / nloc;
        if (old + 1u == (gen + 1u) * nloc) {
            __builtin_amdgcn_fence(__ATOMIC_RELEASE, "agent");
            asm volatile("s_waitcnt vmcnt(0)" ::: "memory");
            const unsigned og = xb_add(&bar[XB_TOP], 1u);
            const unsigned tg = og / nx;
            if (og + 1u == (tg + 1u) * nx) xb_add(&bar[XB_TOPGEN], 1u);
            else XB_SPIN(xb_ld(&bar[XB_TOPGEN]) == tg, bar);
            __builtin_amdgcn_fence(__ATOMIC_ACQUIRE, "agent");
            xb_add(&bar[XB_XGEN(b.x)], 1u);
            asm volatile("s_waitcnt vmcnt(0)" ::: "memory");
        } else {
            XB_SPIN(xb_ld(&bar[XB_XGEN(b.x)]) == gen, bar);
            __builtin_amdgcn_fence(__ATOMIC_ACQUIRE, "agent");
            asm volatile("s_waitcnt vmcnt(0)" ::: "memory");
        }
    }
    __syncthreads();
}

constexpr int NWAVES = 8, NTHR = 512;
constexpr int DM = 1024, MP = 16384, MSMP = 1024, MT = MP + MSMP, NBP = 8, NBS = 128, NMB = NBP + NBS, SEQ = 2048, DSEQ = 8;
constexpr int NINSRC = 8208, NIN = 8448, DFF = 2816, NUP = 2 * DFF, NADA = 6 * DM;
constexpr int NCHUNK = MP / 16 + NBS;
constexpr float EPS = 1e-6f;
constexpr size_t O_Y = 0, O_CMP = 17825792, O_GLP = 17842176, O_CFP = 18890752, O_CMS = 18935808, O_GLS = 19197952, O_CFS = 35975168, O_END = 36696064;
constexpr size_t MiB = 1u << 20;
constexpr size_t WS_CTL = 0, CTL_ZERO_BYTES = 1 * MiB;
constexpr size_t WS_MOD = 1 * MiB, WS_WOUT = 5 * MiB, WS_WUP = 7 * MiB, WS_WDOWN = 18 * MiB, WS_WIN = 24 * MiB, WS_KT = 24 * MiB;
constexpr size_t WS_H = 42 * MiB, WS_UA = 76 * MiB, WS_FA = 110 * MiB, WS_RG = 144 * MiB, WS_QK = 178 * MiB, WS_V = 212 * MiB, WS_LR = 246 * MiB, WS_DEC = 247 * MiB, WS_SSQ = 250 * MiB;
constexpr size_t WS_Y1 = 76 * MiB, WS_H2 = 24 * MiB;
constexpr size_t WS_A = 58 * MiB, WS_G = WS_A + (size_t)MT * DFF * 2, WS_F = 58 * MiB, WS_END = 256 * MiB;
static_assert(WS_G + (size_t)MT * DFF * 2 <= WS_END && WS_SSQ + (size_t)MT * 4 * 8 * 4 <= WS_END && WS_KT + (size_t)NCHUNK * 512 * 32 <= WS_H && WS_WIN + (size_t)NIN * DM * 2 <= WS_H, "ws map");
constexpr int CW_BAR = 4096;
constexpr int RING_OFF = 0, RING_BYTES = 131072, LDSCTL_OFF = RING_BYTES, MISC_OFF = LDSCTL_OFF + 320, LDS_BYTES = 147456;

typedef short s16x4 __attribute__((ext_vector_type(4)));
typedef unsigned u32x2 __attribute__((ext_vector_type(2)));
typedef float f32x2v __attribute__((ext_vector_type(2)));
__device__ __forceinline__ float bf2f(unsigned short b) { return __uint_as_float(((unsigned)b) << 16); }
__device__ __forceinline__ float bflo(unsigned w) { return __uint_as_float(w << 16); }
__device__ __forceinline__ float bfhi(unsigned w) { return __uint_as_float(w & 0xffff0000u); }
__device__ __forceinline__ unsigned cvtpk(float lo, float hi) { return pg8::cvt_pk_bf16(lo, hi); }
__device__ __forceinline__ float wave_sum(float v) {
#pragma unroll
    for (int o = 1; o < 64; o <<= 1) v += __shfl_xor(v, o);
    return v;
}
__device__ __forceinline__ const float* xrow_ptr(const float* xp, const float* xs, int m) { return m < MP ? xp + (size_t)m * DM : xs + (size_t)(m - MP) * DM; }
__device__ __forceinline__ int row_mb(int m) { return m < MP ? (m >> 11) : NBP + ((m - MP) >> 3); }

__device__ __forceinline__ void ada_unit(const float* cp, const float* cs, const float* w_ada, const float* b_ada, float* MOD, LAS unsigned char* lds, int nu, int tid) {
    const int lane = tid & 63, w = tid >> 6, nt = w & 1, ks = w >> 1, g = lane >> 4, c16 = lane & 15;
    const int ncol = nu * 32 + nt * 16 + c16;
    f32x4 acc[9];
#pragma unroll
    for (int i = 0; i < 9; ++i) acc[i] = (f32x4){0.f, 0.f, 0.f, 0.f};
#pragma unroll 1
    for (int q = 0; q < 4; ++q) {
        float wv[2][8];
#pragma unroll
        for (int s = 0; s < 2; ++s)
#pragma unroll
            for (int j = 0; j < 8; ++j) wv[s][j] = w_ada[(size_t)(q * 256 + ks * 64 + s * 32 + 8 * g + j) * NADA + ncol];
        __syncthreads();
#pragma unroll 4
        for (int i = 0; i < 72; ++i) { const int e = i * NTHR + tid, mb = e >> 8, kk = e & 255;
            float cv = 0.f; if (mb < NBP) cv = cp[mb * DM + q * 256 + kk]; else if (mb < NMB) cv = cs[(mb - NBP) * DM + q * 256 + kk];
            const float sv = cv / (1.0f + __expf(-cv));
            *(LAS unsigned short*)(lds + mb * 528 + kk * 2) = (unsigned short)f2bf(sv); }
        __syncthreads();
#pragma unroll
        for (int s = 0; s < 2; ++s) {
            v4u bw; bw.x = cvtpk(wv[s][0], wv[s][1]); bw.y = cvtpk(wv[s][2], wv[s][3]); bw.z = cvtpk(wv[s][4], wv[s][5]); bw.w = cvtpk(wv[s][6], wv[s][7]);
            const bf16x8 B = __builtin_bit_cast(bf16x8, bw);
            const int kcol = ks * 64 + s * 32 + 8 * g;
#pragma unroll
            for (int mt = 0; mt < 9; ++mt) { const bf16x8 A = *(const LAS bf16x8*)(lds + (16 * mt + c16) * 528 + kcol * 2);
                acc[mt] = __builtin_amdgcn_mfma_f32_16x16x32_bf16(A, B, acc[mt], 0, 0, 0); }
        }
    }
    __syncthreads();
    LAS float* red = (LAS float*)lds;
#pragma unroll
    for (int mt = 0; mt < 9; ++mt)
#pragma unroll
        for (int r = 0; r < 4; ++r) red[(w * 144 + 16 * mt + 4 * g + r) * 16 + c16] = acc[mt][r];
    __syncthreads();
    for (int i = 0; i < 9; ++i) { const int e = i * NTHR + tid, mb = e >> 5, col = e & 31, nt2 = col >> 4, c = col & 15;
        float s = 0.f;
#pragma unroll
        for (int k4 = 0; k4 < 4; ++k4) s += red[((k4 * 2 + nt2) * 144 + mb) * 16 + c];
        if (mb < NMB) MOD[(size_t)mb * NADA + nu * 32 + col] = s + b_ada[nu * 32 + col]; }
    __syncthreads();
}
__device__ __forceinline__ void transpose_item(const float* W, int N, int k0, int src0, int valid, bf16* dst, int K, LAS float* scr, int lane) {
#pragma unroll 8
    for (int i = 0; i < 32; ++i) { const int kk = 2 * i + (lane >> 5), cl = lane & 31; scr[kk * 33 + cl] = cl < valid ? W[(size_t)(k0 + kk) * N + src0 + cl] : 0.f; }
    LDS_WAIT(); asm volatile("" ::: "memory");
    const int c = lane & 7;
#pragma unroll
    for (int j = 0; j < 4; ++j) { const int n = (lane >> 3) + 8 * j; const LAS float* s = scr + (8 * c) * 33 + n;
        v4u o; o.x = cvtpk(s[0 * 33], s[1 * 33]); o.y = cvtpk(s[2 * 33], s[3 * 33]); o.z = cvtpk(s[4 * 33], s[5 * 33]); o.w = cvtpk(s[6 * 33], s[7 * 33]);
        *(v4u*)(dst + (size_t)n * K + k0 + 8 * c) = o; }
    LDS_WAIT(); asm volatile("" ::: "memory");
}
__device__ __forceinline__ void win_map(int nb, int& src, int& valid) {
    const int n = nb * 32, pn = n >> 8, c = n & 255, half = c >> 7, cc = c & 127; valid = 32;
    if (pn < 8) src = (half ? 2048 : 1024) + 128 * pn + cc;
    else if (pn < 16) src = (half ? 6160 : 0) + 128 * (pn - 8) + cc;
    else if (pn < 24) src = (half ? 7184 : 5120) + 128 * (pn - 16) + cc;
    else if (pn < 26) src = 3072 + 256 * (pn - 24) + c;
    else if (pn < 28) src = 3584 + 256 * (pn - 26) + c;
    else if (pn < 32) src = 4096 + 256 * (pn - 28) + c;
    else { src = 6144; valid = (c == 0) ? 16 : 0; }
}

struct Args { const float* in[24]; float* out; unsigned char* ws; int ph_lo, ph_hi; };
constexpr int N_PHASES = 12;

__global__ void __launch_bounds__(NTHR, 2) mk_fwd(Args args) {
    extern __shared__ __attribute__((aligned(16))) unsigned char lds_raw[];
    LAS unsigned char* lds = (LAS unsigned char*)lds_raw;
    volatile LAS unsigned* MISC = (volatile LAS unsigned*)(lds + MISC_OFF);
    const int tid = threadIdx.x, lane = tid & 63, wave = __builtin_amdgcn_readfirstlane(tid >> 6);
    const int G = gridDim.x, bx = blockIdx.x;
    const int vcu = (G % 8 == 0) ? (bx % 8) * (G / 8) + bx / 8 : bx;
    const int gw = vcu * NWAVES + wave, NGW = G * NWAVES;
#define ws (args.ws)
#define out (args.out)
#define x_p (args.in[0])
#define x_s (args.in[1])
#define c_p (args.in[2])
#define c_s (args.in[3])
#define st_cm (args.in[4])
#define st_gla (args.in[5])
#define st_cf (args.in[6])
#define w_ada (args.in[7])
#define b_ada (args.in[8])
#define n_pre1 (args.in[9])
#define n_post1 (args.in[10])
#define n_pre2 (args.in[11])
#define n_post2 (args.in[12])
#define w_in (args.in[13])
#define conv_w (args.in[14])
#define conv_b (args.in[15])
#define w_a2 (args.in[16])
#define b_a (args.in[17])
#define gla_norm (args.in[18])
#define w_out (args.in[19])
#define w_up (args.in[20])
#define fconv_w (args.in[21])
#define fconv_b (args.in[22])
#define w_down (args.in[23])
#define ctl ((gu32*)(ws + WS_CTL))
#define MOD ((float*)(ws + WS_MOD))
#define WIN_T ((bf16*)(ws + WS_WIN))
#define WOUT_T ((bf16*)(ws + WS_WOUT))
#define WUP_T ((bf16*)(ws + WS_WUP))
#define WDOWN_T ((bf16*)(ws + WS_WDOWN))
#define HB ((bf16*)(ws + WS_H))
#define UA ((bf16*)(ws + WS_UA))
#define FA ((bf16*)(ws + WS_FA))
#define RG ((bf16*)(ws + WS_RG))
#define QK ((bf16*)(ws + WS_QK))
#define VB ((bf16*)(ws + WS_V))
#define LR ((bf16*)(ws + WS_LR))
#define KT ((bf16*)(ws + WS_KT))
#define DEC ((float*)(ws + WS_DEC))
#define SSQ ((float*)(ws + WS_SSQ))
#define ORAW ((bf16*)(out + O_Y))
#define Y1 ((float*)(ws + WS_Y1))
#define H2 ((bf16*)(ws + WS_H2))
#define AB ((bf16*)(ws + WS_A))
#define GB ((bf16*)(ws + WS_G))
#define FB ((float*)(ws + WS_F))
    for (int u = tid; u < (LDS_BYTES - LDSCTL_OFF) / 4; u += NTHR) ((LAS unsigned*)(lds + LDSCTL_OFF))[u] = 0u;
    __syncthreads();
    const int lo = args.ph_lo, hi = args.ph_hi;
    const bool multi = (hi - lo) > 1;
    XcdBarrier bar; bar.bar = (unsigned*)(ctl + CW_BAR); bar.x = 0; bar.st = nullptr;
    if (multi) bar = xcd_barrier_post((unsigned*)(ctl + CW_BAR), MISC + 8);
#ifndef PH_MASK
#define PH_MASK 0xfff
#endif
#define IN(k) ((((PH_MASK) >> (k)) & 1) && lo <= (k) && (k) < hi)
#define SEAM(k) do { if (IN(k) && IN((k) + 1)) xcd_barrier(bar); } while (0)

    if (IN(0)) {
        for (int nu = bx; nu < NADA / 32; nu += G) ada_unit(c_p, c_s, w_ada, b_ada, MOD, lds, nu, tid);
        LAS float* scr = (LAS float*)(lds + wave * 16384);
        constexpr int I_IN = 16 * (NIN / 32), I_OUT = 16 * (DM / 32), I_UP = 16 * (NUP / 32), I_DOWN = (DFF / 64) * (DM / 32), NITEMS = I_IN + I_OUT + I_UP + I_DOWN;
        for (int it = NGW - 1 - gw; it < NITEMS; it += NGW) {
            int r = it;
            if (r < I_IN) { const int kb = r / (NIN / 32), nb = r % (NIN / 32); int src, valid; win_map(nb, src, valid);
                transpose_item(w_in, NINSRC, 64 * kb, src, valid, WIN_T + (size_t)nb * 32 * DM, DM, scr, lane); continue; } r -= I_IN;
            if (r < I_OUT) { const int kb = r / (DM / 32), nb = r % (DM / 32);
                transpose_item(w_out, DM, 64 * kb, 32 * nb, 32, WOUT_T + (size_t)nb * 32 * DM, DM, scr, lane); continue; } r -= I_OUT;
            if (r < I_UP) { const int kb = r / (NUP / 32), nb = r % (NUP / 32); const int n = nb * 32, pn = n >> 8, c = n & 255;
                const int src = (c < 128) ? 128 * pn + c : DFF + 128 * pn + (c - 128);
                transpose_item(w_up, NUP, 64 * kb, src, 32, WUP_T + (size_t)nb * 32 * DM, DM, scr, lane); continue; } r -= I_UP;
            { const int kb = r / (DM / 32), nb = r % (DM / 32);
                transpose_item(w_down, DM, 64 * kb, 32 * nb, 32, WDOWN_T + (size_t)nb * 32 * DFF, DFF, scr, lane); }
        }
    }
    SEAM(0);
    if (IN(1)) {
        for (int m = gw; m < MT; m += NGW) {
            const f32x4* xr = (const f32x4*)xrow_ptr(x_p, x_s, m) + lane; const int mb = row_mb(m);
            const f32x4* sh = (const f32x4*)(MOD + (size_t)mb * NADA) + lane; const f32x4* sc = (const f32x4*)(MOD + (size_t)mb * NADA + DM) + lane; const f32x4* gp = (const f32x4*)n_pre1 + lane;
            f32x4 v[4]; float s = 0.f;
#pragma unroll
            for (int j = 0; j < 4; ++j) { v[j] = xr[64 * j]; s += (v[j].x * v[j].x + v[j].y * v[j].y) + (v[j].z * v[j].z + v[j].w * v[j].w); }
            const float rstd = rsqrtf(wave_sum(s) * (1.f / DM) + EPS);
            u32x2* o8 = (u32x2*)(HB + (size_t)m * DM) + lane;
#pragma unroll
            for (int j = 0; j < 4; ++j) { const f32x4 g4 = gp[64 * j], c4 = sc[64 * j], h4 = sh[64 * j]; const f32x4 o = (v[j] * rstd) * g4 * (c4 + 1.0f) + h4;
                u32x2 w; w.x = cvtpk(o.x, o.y); w.y = cvtpk(o.z, o.w); o8[64 * j] = w; }
        }
    }
    SEAM(1);
    if (IN(2)) {
        pg8::Gemm g{HB, WIN_T, MT, NIN, DM}; pg8::StaticOrder S; S.init(MT, NIN, G, bx);
        pg8::EpiProj E{UA, (size_t)(WS_FA - WS_UA) / 2};
        static_assert(WS_RG - WS_UA == 2 * (WS_FA - WS_UA) && WS_QK - WS_UA == 3 * (WS_FA - WS_UA) && WS_V - WS_UA == 4 * (WS_FA - WS_UA) && WS_LR - WS_UA == 5 * (WS_FA - WS_UA), "proj map");
        pg8::gemm_phase<pg8::EpiProj, pg8::StaticOrder, true, true>(lds + RING_OFF, g, S, E);
    }
    SEAM(2);
    if (IN(3)) {
        const int col = tid;
        float wa[16];
#pragma unroll
        for (int r = 0; r < 16; ++r) wa[r] = w_a2[r * 512 + col];
        const float ba = b_a[col];
        for (int chunk = vcu; chunk < NCHUNK; chunk += G) {
            const bool smp = chunk >= MP / 16; const int row0 = smp ? MP + (chunk - MP / 16) * DSEQ : chunk * 16; const int T = smp ? DSEQ : 16;
            float bcum[16]; float bc = 0.f;
#pragma unroll
            for (int t = 0; t < 16; ++t) { bcum[t] = 0.f;
                if (t < T) { const v4u l0 = *(const v4u*)(LR + (size_t)(row0 + t) * 16), l1 = *(const v4u*)(LR + (size_t)(row0 + t) * 16 + 8);
                    float xv = ba;
                    xv += bflo(l0.x) * wa[0] + bfhi(l0.x) * wa[1] + bflo(l0.y) * wa[2] + bfhi(l0.y) * wa[3] + bflo(l0.z) * wa[4] + bfhi(l0.z) * wa[5] + bflo(l0.w) * wa[6] + bfhi(l0.w) * wa[7];
                    xv += bflo(l1.x) * wa[8] + bfhi(l1.x) * wa[9] + bflo(l1.y) * wa[10] + bfhi(l1.y) * wa[11] + bflo(l1.z) * wa[12] + bfhi(l1.z) * wa[13] + bflo(l1.w) * wa[14] + bfhi(l1.w) * wa[15];
                    const float ls = fminf(xv, 0.f) - log1pf(__expf(-fabsf(xv)));
                    bc += ls * (1.0f / 16.0f); bcum[t] = bc; } }
            const float blast = bc;
            float kh[16];
#pragma unroll
            for (int t = 0; t < 16; ++t) { kh[t] = 0.f;
                if (t < T) { bf16* qp = QK + (size_t)(row0 + t) * DM + col; const float qv = bf2f(qp[0]), kv = bf2f(qp[512]);
                    const float eq = __expf(bcum[t]);
                    qp[0] = (bf16)f2bf(qv * 0.08838834764831845f * eq); qp[512] = (bf16)f2bf(kv * __expf(-bcum[t])); kh[t] = kv * __expf(blast - bcum[t]); } }
            v4u k0, k1; k0.x = cvtpk(kh[0], kh[1]); k0.y = cvtpk(kh[2], kh[3]); k0.z = cvtpk(kh[4], kh[5]); k0.w = cvtpk(kh[6], kh[7]);
            k1.x = cvtpk(kh[8], kh[9]); k1.y = cvtpk(kh[10], kh[11]); k1.z = cvtpk(kh[12], kh[13]); k1.w = cvtpk(kh[14], kh[15]);
            v4u* kt = (v4u*)(KT + ((size_t)chunk * 512 + col) * 16); kt[0] = k0; kt[1] = k1;
            DEC[(size_t)chunk * 512 + col] = __expf(blast);
        }
    }
    SEAM(3);
    if (IN(4)) {
        constexpr int NT = 2, NSL = 256 / (16 * NT);
        const int c16 = lane & 15, g = lane >> 4;
        constexpr int NU_P = NBP * 4 * NSL, NU_S = NBS * 4 * NSL;
        for (int un = wave * G + vcu; un < NU_P + NU_S; un += NGW) {
            const bool smp = un >= NU_P; const int uu = smp ? un - NU_P : un;
            const int sl = uu % NSL, h = (uu / NSL) & 3, b = uu / (NSL * 4);
            const int nchunks = smp ? 1 : SEQ / 16, T = smp ? DSEQ : 16;
            const int row_base = smp ? MP + b * DSEQ : b * SEQ, chunk_base = smp ? MP / 16 + b : b * (SEQ / 16);
            const int v0 = h * 256 + sl * 16 * NT + NT * c16;
            f32x4 S[8][NT];
            if (smp) { const float* s0 = st_gla + ((size_t)(b * 4 + h) * 128) * 256 + (v0 - h * 256);
#pragma unroll
                for (int mt = 0; mt < 8; ++mt)
#pragma unroll
                    for (int r = 0; r < 4; ++r) { const f32x2v t2 = *(const f32x2v*)(s0 + (size_t)(16 * mt + 4 * g + r) * 256); S[mt][0][r] = t2.x; S[mt][1][r] = t2.y; }
            } else {
#pragma unroll
                for (int mt = 0; mt < 8; ++mt)
#pragma unroll
                    for (int nt = 0; nt < NT; ++nt) S[mt][nt] = (f32x4){0.f, 0.f, 0.f, 0.f};
            }
            for (int c = 0; c < nchunks; ++c) {
                const int r0 = row_base + c * 16, chunk = chunk_base + c;
                bf16x8 Qf[4], Kf[4];
                const bool vrow = c16 < T;
                const bf16* qrow = QK + (size_t)(r0 + (vrow ? c16 : 0)) * DM + h * 128 + 4 * g;
#pragma unroll
                for (int s = 0; s < 4; ++s) {
                    u32x2 a0 = *(const u32x2*)(qrow + 32 * s), a1 = *(const u32x2*)(qrow + 32 * s + 16), b0 = *(const u32x2*)(qrow + 512 + 32 * s), b1 = *(const u32x2*)(qrow + 512 + 32 * s + 16);
                    if (!vrow) { a0 = (u32x2){0u, 0u}; a1 = a0; b0 = a0; b1 = a0; }
                    Qf[s] = __builtin_bit_cast(bf16x8, (v4u){a0.x, a0.y, a1.x, a1.y}); Kf[s] = __builtin_bit_cast(bf16x8, (v4u){b0.x, b0.y, b1.x, b1.y});
                }
                bf16x8 KTf[8];
#pragma unroll
                for (int mt = 0; mt < 8; ++mt) { const u32x2 kk2 = *(const u32x2*)(KT + ((size_t)chunk * 512 + h * 128 + 16 * mt + c16) * 16 + 4 * g); KTf[mt] = __builtin_bit_cast(bf16x8, (v4u){kk2.x, kk2.y, 0u, 0u}); }
                bf16x8 Vf[NT];
                {
                    unsigned short vv[4][NT];
#pragma unroll
                    for (int j = 0; j < 4; ++j) { const bool ok = (4 * g + j) < T; const unsigned w2 = ok ? *(const unsigned*)(VB + (size_t)(r0 + 4 * g + j) * DM + v0) : 0u;
                        vv[j][0] = (unsigned short)(w2 & 0xffffu); vv[j][1] = (unsigned short)(w2 >> 16); }
#pragma unroll
                    for (int nt = 0; nt < NT; ++nt) Vf[nt] = (bf16x8){(short)vv[0][nt], (short)vv[1][nt], (short)vv[2][nt], (short)vv[3][nt], 0, 0, 0, 0};
                }
                f32x4 dec[8];
#pragma unroll
                for (int mt = 0; mt < 8; ++mt) dec[mt] = *(const f32x4*)(DEC + (size_t)chunk * 512 + h * 128 + 16 * mt + 4 * g);
                f32x4 PT = (f32x4){0.f, 0.f, 0.f, 0.f};
#pragma unroll
                for (int s = 0; s < 4; ++s) PT = __builtin_amdgcn_mfma_f32_16x16x32_bf16(Kf[s], Qf[s], PT, 0, 0, 0);
#pragma unroll
                for (int r = 0; r < 4; ++r) if (4 * g + r > c16) PT[r] = 0.f;
                const bf16x8 Pf = __builtin_bit_cast(bf16x8, (v4u){cvtpk(PT[0], PT[1]), cvtpk(PT[2], PT[3]), 0u, 0u});
                f32x4 o[NT];
#pragma unroll
                for (int nt = 0; nt < NT; ++nt) {
                    o[nt] = __builtin_amdgcn_mfma_f32_16x16x32_bf16(Pf, Vf[nt], (f32x4){0.f, 0.f, 0.f, 0.f}, 0, 0, 0);
#pragma unroll
                    for (int s = 0; s < 4; ++s) {
                        const f32x4 sa = S[2 * s][nt], sb = S[2 * s + 1][nt];
                        const bf16x8 Sb = __builtin_bit_cast(bf16x8, (v4u){cvtpk(sa[0], sa[1]), cvtpk(sa[2], sa[3]), cvtpk(sb[0], sb[1]), cvtpk(sb[2], sb[3])});
                        o[nt] = __builtin_amdgcn_mfma_f32_16x16x32_bf16(Qf[s], Sb, o[nt], 0, 0, 0);
                    }
                }
#pragma unroll
                for (int mt = 0; mt < 8; ++mt)
#pragma unroll
                    for (int nt = 0; nt < NT; ++nt) S[mt][nt] = __builtin_amdgcn_mfma_f32_16x16x32_bf16(KTf[mt], Vf[nt], S[mt][nt] * dec[mt], 0, 0, 0);
#pragma unroll
                for (int r = 0; r < 4; ++r) {
                    float ss = o[0][r] * o[0][r] + o[1][r] * o[1][r];
                    ss += __shfl_xor(ss, 1); ss += __shfl_xor(ss, 2); ss += __shfl_xor(ss, 4); ss += __shfl_xor(ss, 8);
                    if (4 * g + r < T) { const int row = r0 + 4 * g + r;
                        *(unsigned*)(ORAW + (size_t)row * DM + v0) = cvtpk(o[0][r], o[1][r]);
                        if (c16 == 0) SSQ[((size_t)row * 4 + h) * NSL + sl] = ss; }
                }
            }
            float* so = out + (smp ? O_GLS : O_GLP) + ((size_t)(b * 4 + h) * 128) * 256 + (v0 - h * 256);
#pragma unroll
            for (int mt = 0; mt < 8; ++mt)
#pragma unroll
                for (int r = 0; r < 4; ++r) *(f32x2v*)(so + (size_t)(16 * mt + 4 * g + r) * 256) = (f32x2v){S[mt][0][r], S[mt][1][r]};
        }
    }
    SEAM(4);
    if (IN(5)) {
        constexpr int NSL = 8;
        const int nitems = NCHUNK * 128;
        for (int it = vcu * NTHR + tid; it < nitems; it += G * NTHR) {
            const int cg = it & 127, run = it >> 7, ch = cg * 8, h = cg >> 5;
            const bool smp = run >= MP / 16; const int row0 = smp ? MP + (run - MP / 16) * DSEQ : run * 16; const int T = smp ? DSEQ : 16;
            float w0[8], w1[8], w2[8], cb[8], gn[8];
#pragma unroll
            for (int i = 0; i < 8; ++i) { w0[i] = conv_w[ch + i]; w1[i] = conv_w[DM + ch + i]; w2[i] = conv_w[2 * DM + ch + i]; cb[i] = conv_b[ch + i]; gn[i] = gla_norm[ch + i]; }
            float um2[8], um1[8];
            if (smp) { const float* st = st_cm + (size_t)(run - MP / 16) * 2 * DM + ch;
#pragma unroll
                for (int i = 0; i < 8; ++i) { um2[i] = st[i]; um1[i] = st[DM + i]; }
            } else if ((run & 127) == 0) {
#pragma unroll
                for (int i = 0; i < 8; ++i) { um2[i] = 0.f; um1[i] = 0.f; }
            } else { const v4u a = *(const v4u*)(UA + (size_t)(row0 - 2) * DM + ch), b = *(const v4u*)(UA + (size_t)(row0 - 1) * DM + ch);
                um2[0] = bflo(a.x); um2[1] = bfhi(a.x); um2[2] = bflo(a.y); um2[3] = bfhi(a.y); um2[4] = bflo(a.z); um2[5] = bfhi(a.z); um2[6] = bflo(a.w); um2[7] = bfhi(a.w);
                um1[0] = bflo(b.x); um1[1] = bfhi(b.x); um1[2] = bflo(b.y); um1[3] = bfhi(b.y); um1[4] = bflo(b.z); um1[5] = bfhi(b.z); um1[6] = bflo(b.w); um1[7] = bfhi(b.w); }
            for (int t = 0; t < T; ++t) {
                const size_t ro = (size_t)(row0 + t) * DM + ch;
                const v4u ua = *(const v4u*)(UA + ro), fa = *(const v4u*)(FA + ro), rg = *(const v4u*)(RG + ro), ob = *(const v4u*)(ORAW + ro);
                const f32x4 s0 = *(const f32x4*)(SSQ + ((size_t)(row0 + t) * 4 + h) * NSL), s1 = *(const f32x4*)(SSQ + ((size_t)(row0 + t) * 4 + h) * NSL + 4);
                const float rs = rsqrtf(((s0.x + s0.y) + (s0.z + s0.w) + (s1.x + s1.y) + (s1.z + s1.w)) * (1.0f / 256.0f) + EPS);
                float u[8], f[8], q[8], ov[8];
                u[0] = bflo(ua.x); u[1] = bfhi(ua.x); u[2] = bflo(ua.y); u[3] = bfhi(ua.y); u[4] = bflo(ua.z); u[5] = bfhi(ua.z); u[6] = bflo(ua.w); u[7] = bfhi(ua.w);
                f[0] = bflo(fa.x); f[1] = bfhi(fa.x); f[2] = bflo(fa.y); f[3] = bfhi(fa.y); f[4] = bflo(fa.z); f[5] = bfhi(fa.z); f[6] = bflo(fa.w); f[7] = bfhi(fa.w);
                q[0] = bflo(rg.x); q[1] = bfhi(rg.x); q[2] = bflo(rg.y); q[3] = bfhi(rg.y); q[4] = bflo(rg.z); q[5] = bfhi(rg.z); q[6] = bflo(rg.w); q[7] = bfhi(rg.w);
                ov[0] = bflo(ob.x); ov[1] = bfhi(ob.x); ov[2] = bflo(ob.y); ov[3] = bfhi(ob.y); ov[4] = bflo(ob.z); ov[5] = bfhi(ob.z); ov[6] = bflo(ob.w); ov[7] = bfhi(ob.w);
                float mo[8];
#pragma unroll
                for (int i = 0; i < 8; ++i) { const float cv = cb[i] + w0[i] * um2[i] + w1[i] * um1[i] + w2[i] * u[i];
                    mo[i] = f[i] * cv + q[i] * gn[i] * ov[i] * rs; um2[i] = um1[i]; um1[i] = u[i]; }
                v4u w; w.x = cvtpk(mo[0], mo[1]); w.y = cvtpk(mo[2], mo[3]); w.z = cvtpk(mo[4], mo[5]); w.w = cvtpk(mo[6], mo[7]);
                *(v4u*)(HB + ro) = w;
            }
            if (smp || (run & 127) == 127) {
                float* cs = smp ? out + O_CMS + (size_t)(run - MP / 16) * 2 * DM + ch : out + O_CMP + (size_t)(run >> 7) * 2 * DM + ch;
#pragma unroll
                for (int i = 0; i < 8; ++i) { cs[i] = um2[i]; cs[DM + i] = um1[i]; }
            }
        }
    }
    SEAM(5);
    if (IN(6)) {
        pg8::Gemm g{HB, WOUT_T, MT, DM, DM}; pg8::StaticOrder S; S.init(MT, DM, G, bx);
        pg8::EpiF32 E{Y1, DM};
        pg8::gemm_phase<pg8::EpiF32, pg8::StaticOrder, true, true>(lds + RING_OFF, g, S, E);
    }
    SEAM(6);
    if (IN(7)) {
        for (int m = gw; m < MT; m += NGW) {
            const f32x4* xr = (const f32x4*)xrow_ptr(x_p, x_s, m) + lane; const f32x4* yr = (const f32x4*)(Y1 + (size_t)m * DM) + lane; const int mb = row_mb(m);
            const float* mod = MOD + (size_t)mb * NADA;
            const f32x4* g1 = (const f32x4*)(mod + 2 * DM) + lane; const f32x4* sh2 = (const f32x4*)(mod + 3 * DM) + lane; const f32x4* sc2 = (const f32x4*)(mod + 4 * DM) + lane;
            const f32x4* np1 = (const f32x4*)n_post1 + lane; const f32x4* np2 = (const f32x4*)n_pre2 + lane;
            f32x4 y[4]; float s = 0.f;
#pragma unroll
            for (int j = 0; j < 4; ++j) { y[j] = yr[64 * j]; s += (y[j].x * y[j].x + y[j].y * y[j].y) + (y[j].z * y[j].z + y[j].w * y[j].w); }
            const float rstd = rsqrtf(wave_sum(s) * (1.f / DM) + EPS);
            f32x4 x1[4]; float s2 = 0.f; f32x4* xo = (f32x4*)(out + O_Y + (size_t)m * DM) + lane;
#pragma unroll
            for (int j = 0; j < 4; ++j) { x1[j] = xr[64 * j] + g1[64 * j] * ((y[j] * rstd) * np1[64 * j]); xo[64 * j] = x1[j];
                s2 += (x1[j].x * x1[j].x + x1[j].y * x1[j].y) + (x1[j].z * x1[j].z + x1[j].w * x1[j].w); }
            const float rstd2 = rsqrtf(wave_sum(s2) * (1.f / DM) + EPS);
            u32x2* o8 = (u32x2*)(H2 + (size_t)m * DM) + lane;
#pragma unroll
            for (int j = 0; j < 4; ++j) { const f32x4 o = (x1[j] * rstd2) * np2[64 * j] * (sc2[64 * j] + 1.0f) + sh2[64 * j];
                u32x2 w; w.x = cvtpk(o.x, o.y); w.y = cvtpk(o.z, o.w); o8[64 * j] = w; }
        }
    }
    SEAM(7);
    if (IN(8)) {
        pg8::Gemm g{H2, WUP_T, MT, NUP, DM}; pg8::StaticOrder S; S.init(MT, NUP, G, bx);
        pg8::EpiUp E{AB, GB, DFF};
        pg8::gemm_phase<pg8::EpiUp, pg8::StaticOrder, true, true>(lds + RING_OFF, g, S, E);
    }
    SEAM(8);
    if (IN(9)) {
        constexpr int NCG = DFF / 8;
        const int nitems = NCHUNK * NCG;
        for (int it = vcu * NTHR + tid; it < nitems; it += G * NTHR) {
            const int cg = it % NCG, run = it / NCG, ch = cg * 8;
            const bool smp = run >= MP / 16; const int row0 = smp ? MP + (run - MP / 16) * DSEQ : run * 16; const int T = smp ? DSEQ : 16;
            float w0[8], w1[8], w2[8], cb[8];
#pragma unroll
            for (int i = 0; i < 8; ++i) { w0[i] = fconv_w[ch + i]; w1[i] = fconv_w[DFF + ch + i]; w2[i] = fconv_w[2 * DFF + ch + i]; cb[i] = fconv_b[ch + i]; }
            float am2[8], am1[8];
            if (smp) { const float* st = st_cf + (size_t)(run - MP / 16) * 2 * DFF + ch;
#pragma unroll
                for (int i = 0; i < 8; ++i) { am2[i] = st[i]; am1[i] = st[DFF + i]; }
            } else if ((run & 127) == 0) {
#pragma unroll
                for (int i = 0; i < 8; ++i) { am2[i] = 0.f; am1[i] = 0.f; }
            } else { const v4u a = *(const v4u*)(AB + (size_t)(row0 - 2) * DFF + ch), b = *(const v4u*)(AB + (size_t)(row0 - 1) * DFF + ch);
                am2[0] = bflo(a.x); am2[1] = bfhi(a.x); am2[2] = bflo(a.y); am2[3] = bfhi(a.y); am2[4] = bflo(a.z); am2[5] = bfhi(a.z); am2[6] = bflo(a.w); am2[7] = bfhi(a.w);
                am1[0] = bflo(b.x); am1[1] = bfhi(b.x); am1[2] = bflo(b.y); am1[3] = bfhi(b.y); am1[4] = bflo(b.z); am1[5] = bfhi(b.z); am1[6] = bflo(b.w); am1[7] = bfhi(b.w); }
            for (int t = 0; t < T; ++t) {
                const size_t ro = (size_t)(row0 + t) * DFF + ch;
                const v4u aa = *(const v4u*)(AB + ro), gg = *(const v4u*)(GB + ro);
                float a[8], gv[8];
                a[0] = bflo(aa.x); a[1] = bfhi(aa.x); a[2] = bflo(aa.y); a[3] = bfhi(aa.y); a[4] = bflo(aa.z); a[5] = bfhi(aa.z); a[6] = bflo(aa.w); a[7] = bfhi(aa.w);
                gv[0] = bflo(gg.x); gv[1] = bfhi(gg.x); gv[2] = bflo(gg.y); gv[3] = bfhi(gg.y); gv[4] = bflo(gg.z); gv[5] = bfhi(gg.z); gv[6] = bflo(gg.w); gv[7] = bfhi(gg.w);
                float uo[8];
#pragma unroll
                for (int i = 0; i < 8; ++i) { const float cv = cb[i] + w0[i] * am2[i] + w1[i] * am1[i] + w2[i] * a[i];
                    const float z = 0.7978845608028654f * (cv + 0.044715f * cv * cv * cv);
                    const float th = 1.0f - 2.0f * __builtin_amdgcn_rcpf(1.0f + __builtin_amdgcn_exp2f(2.885390081777927f * z));
                    uo[i] = 0.5f * cv * (1.0f + th) * gv[i]; am2[i] = am1[i]; am1[i] = a[i]; }
                v4u w; w.x = cvtpk(uo[0], uo[1]); w.y = cvtpk(uo[2], uo[3]); w.z = cvtpk(uo[4], uo[5]); w.w = cvtpk(uo[6], uo[7]);
                *(v4u*)(GB + ro) = w;
            }
            if (smp || (run & 127) == 127) {
                float* cs = smp ? out + O_CFS + (size_t)(run - MP / 16) * 2 * DFF + ch : out + O_CFP + (size_t)(run >> 7) * 2 * DFF + ch;
#pragma unroll
                for (int i = 0; i < 8; ++i) { cs[i] = am2[i]; cs[DFF + i] = am1[i]; }
            }
        }
    }
    SEAM(9);
    if (IN(10)) {
        pg8::Gemm g{GB, WDOWN_T, MT, DM, DFF}; pg8::StaticOrder S; S.init(MT, DM, G, bx);
        pg8::EpiF32 E{FB, DM};
        pg8::gemm_phase<pg8::EpiF32, pg8::StaticOrder, true, true>(lds + RING_OFF, g, S, E);
    }
    SEAM(10);
    if (IN(11)) {
        for (int m = gw; m < MT; m += NGW) {
            const f32x4* fr_ = (const f32x4*)(FB + (size_t)m * DM) + lane; const int mb = row_mb(m);
            const f32x4* g2 = (const f32x4*)(MOD + (size_t)mb * NADA + 5 * DM) + lane; const f32x4* np = (const f32x4*)n_post2 + lane;
            f32x4 y[4]; float s = 0.f;
#pragma unroll
            for (int j = 0; j < 4; ++j) { y[j] = fr_[64 * j]; s += (y[j].x * y[j].x + y[j].y * y[j].y) + (y[j].z * y[j].z + y[j].w * y[j].w); }
            const float rstd = rsqrtf(wave_sum(s) * (1.f / DM) + EPS);
            f32x4* xo = (f32x4*)(out + O_Y + (size_t)m * DM) + lane;
#pragma unroll
            for (int j = 0; j < 4; ++j) xo[64 * j] = xo[64 * j] + g2[64 * j] * ((y[j] * rstd) * np[64 * j]);
        }
    }
#undef IN
#undef SEAM
}
#undef ws
#undef out
#undef x_p
#undef x_s
#undef c_p
#undef c_s
#undef st_cm
#undef st_gla
#undef st_cf
#undef w_ada
#undef b_ada
#undef n_pre1
#undef n_post1
#undef n_pre2
#undef n_post2
#undef w_in
#undef conv_w
#undef conv_b
#undef w_a2
#undef b_a
#undef gla_norm
#undef w_out
#undef w_up
#undef fconv_w
#undef fconv_b
#undef w_down
#undef ctl
#undef MOD
#undef WIN_T
#undef WOUT_T
#undef WUP_T
#undef WDOWN_T
#undef HB
#undef UA
#undef FA
#undef RG
#undef QK
#undef VB
#undef LR
#undef KT
#undef DEC
#undef SSQ
#undef ORAW
#undef Y1
#undef H2
#undef AB
#undef GB
#undef FB


#ifdef DBG_STOP
__global__ void dbg_fold(const unsigned short* src, size_t n, float* o, size_t n_out) {
    for (size_t i = (size_t)blockIdx.x * blockDim.x + threadIdx.x; i < n_out; i += (size_t)gridDim.x * blockDim.x) {
        unsigned h = 0; for (size_t j = i; j < n; j += n_out) h = h * 31u + src[j];
        o[i] = (float)(h & 0xfffffu) * (1.0f / 1048576.0f);
    }
}
#endif
#ifndef MK_N_LAUNCHES
#define MK_N_LAUNCHES 1
#endif
extern "C" void kernel_launch(void* const* d_in, const int* in_sizes, int n_in, void* d_out, int out_size, void* d_ws, size_t ws_size, hipStream_t stream) {
    static int grid = 0;
    if (grid == 0) {
        if (n_in != 24 || (size_t)out_size != O_END || ws_size < WS_END) { fprintf(stderr, "kernel_launch: unexpected problem (n_in %d out %d ws %zu)\n", n_in, out_size, ws_size); grid = -1; return; }
        int dev = 0, cus = 0;
        if (hipGetDevice(&dev) != hipSuccess || hipDeviceGetAttribute(&cus, hipDeviceAttributeMultiprocessorCount, dev) != hipSuccess) { grid = -1; return; }
        if (hipFuncSetAttribute((const void*)mk_fwd, hipFuncAttributeMaxDynamicSharedMemorySize, LDS_BYTES) != hipSuccess) { fprintf(stderr, "kernel_launch: hipFuncSetAttribute failed\n"); grid = -1; return; }
        int per_cu = 0;
        if (hipOccupancyMaxActiveBlocksPerMultiprocessor(&per_cu, (const void*)mk_fwd, NTHR, LDS_BYTES) != hipSuccess || per_cu < 1) { fprintf(stderr, "kernel_launch: occupancy query says %d\n", per_cu); }
        (void)hipGetLastError();
        grid = cus;
    }
    if (grid < 0) return;
    (void)hipMemsetAsync((char*)d_ws + WS_CTL, 0, CTL_ZERO_BYTES, stream);
    Args a{};
    for (int i = 0; i < 24; ++i) a.in[i] = (const float*)d_in[i];
    a.out = (float*)d_out; a.ws = (unsigned char*)d_ws;
    if (MK_N_LAUNCHES == 1) {
        a.ph_lo = 0; a.ph_hi = N_PHASES;
        void* kargs[] = {&a};
        hipError_t e = hipLaunchCooperativeKernel((const void*)mk_fwd, dim3(grid), dim3(NTHR), kargs, LDS_BYTES, stream);
        if (e != hipSuccess) fprintf(stderr, "kernel_launch: cooperative launch failed: %s\n", hipGetErrorString(e));
    } else {
#ifdef DBG_STOP
        for (int p = 0; p <= DBG_STOP; ++p) { a.ph_lo = p; a.ph_hi = p + 1; hipLaunchKernelGGL(mk_fwd, dim3(grid), dim3(NTHR), LDS_BYTES, stream, a); }
        hipLaunchKernelGGL(dbg_fold, dim3(2048), dim3(256), 0, stream, (const unsigned short*)((const char*)d_ws + DBG_LO * MiB), (size_t)(DBG_HI - DBG_LO) * MiB / 2, (float*)d_out, (size_t)O_END);
#else
        for (int p = 0; p < N_PHASES; ++p) { a.ph_lo = p; a.ph_hi = p + 1; hipLaunchKernelGGL(mk_fwd, dim3(grid), dim3(NTHR), LDS_BYTES, stream, a); }
#endif
    }
}
```

```cpp
#include <hip/hip_runtime.h>
#include <cstdio>
#include <cstdint>
namespace pg8 {
#define PG8_LAS __attribute__((address_space(3)))
typedef unsigned short bf16_t;
typedef short bf16x8 __attribute__((ext_vector_type(8)));
typedef float f32x4 __attribute__((ext_vector_type(4)));
typedef unsigned u32x4 __attribute__((ext_vector_type(4)));
constexpr int BM = 256, BK = 64, HALF = 128, HTB = HALF * BK * 2  , STAGE_BYTES = 8 * HTB, NXCD = 8, WGM = 8;

__host__ __device__ __forceinline__ int lds_byte(int r, int c) { const int st = (r >> 4) * 2 + (c >> 5), rr = r & 15, cc = c & 31, ob = rr * 64 + cc * 2; return st * 1024 + (ob ^ (((ob >> 9) & 1) << 5)); }
__host__ __device__ __forceinline__ void stage_rc(int b, int& R, int& C) { const int st = b / 1024, sb = b % 1024, swz = sb ^ (((sb >> 9) & 1) << 5); R = (st >> 1) * 16 + swz / 64; C = (st & 1) * 32 + (swz % 64) / 2; }
__host__ __device__ __forceinline__ int perm32(int rho) { const int n = rho >> 4, i = rho & 15; return 8 * (i >> 2) + 4 * n + (i & 3); }

struct Unit { int pm, pn; };
struct Gemm { const bf16_t* A; const bf16_t* Bt; int M, N, K; };

struct StaticOrder {
    int nM, nN, nwg, G, c;
    __host__ __device__ void init(int M, int N, int G_, int c_) { nM = M / BM; nN = N / BM; nwg = nM * nN; G = G_; c = c_; }
    __host__ __device__ bool next(int i, Unit& u) const {
        const long L = (long)i * G + c; if (L >= nwg) return false;
        int wgid = (int)L; { const int q = nwg / NXCD, r = nwg % NXCD, xcd = wgid % NXCD, off = wgid / NXCD; wgid = (xcd < r ? xcd * (q + 1) : r * (q + 1) + (xcd - r) * q) + off; }
        const int nig = WGM * nN, gid = wgid / nig, fm = gid * WGM, gsz = (nM - fm) < WGM ? (nM - fm) : WGM;
        u.pm = fm + ((wgid % nig) % gsz); u.pn = (wgid % nig) / gsz; return true;
    }
    __device__ __forceinline__ void a_ready(const Unit&) const {}
    __device__ __forceinline__ void done(const Unit&) const {}
};

typedef float f32x2 __attribute__((ext_vector_type(2)));
typedef __bf16 bf16x2v __attribute__((ext_vector_type(2)));
__device__ __forceinline__ unsigned cvt_pk_bf16(float lo, float hi) { f32x2 v = {lo, hi}; bf16x2v b = __builtin_convertvector(v, bf16x2v); return __builtin_bit_cast(unsigned, b); }
__device__ __forceinline__ float sigmoidf_fast(float y) { return __builtin_amdgcn_rcpf(1.0f + __builtin_amdgcn_exp2f(-1.4426950408889634f * y)); }

struct EpiF32 {
    static constexpr bool PERM = false, AFTER_DRAIN = false;
    float* C; int ldc;
    __device__ __forceinline__ void operator()(const f32x4 (&acc)[2][2][4][2], const Unit& u, int wr, int wc, int fr, int fq) const {
        const int row0 = u.pm * BM + wr * 64 + fr, col0 = u.pn * BM + wc * 32 + 4 * fq;
#pragma unroll
        for (int ai = 0; ai < 2; ++ai)
#pragma unroll
            for (int m = 0; m < 4; ++m) { float* rowp = C + (size_t)(row0 + ai * HALF + m * 16) * ldc + col0;
#pragma unroll
                for (int bj = 0; bj < 2; ++bj)
#pragma unroll
                    for (int n = 0; n < 2; ++n) *(f32x4*)(rowp + bj * HALF + n * 16) = acc[ai][bj][m][n]; }
    }
};

struct EpiProj {
    static constexpr bool PERM = true, AFTER_DRAIN = false;
    bf16_t* P; size_t S;
    __device__ __forceinline__ void operator()(const f32x4 (&acc)[2][2][4][2], const Unit& u, int wr, int wc, int fr, int fq) const {
        const int row0 = u.pm * BM + wr * 64 + fr, cl = wc * 32 + 8 * fq, pn = u.pn;
        if (pn < 24) {
            const int type = pn >> 3; bf16_t* base = P + (size_t)type * S + 128 * (pn & 7) + cl;
#pragma unroll
            for (int ai = 0; ai < 2; ++ai)
#pragma unroll
                for (int m = 0; m < 4; ++m) {
                    const f32x4 x0 = acc[ai][0][m][0], x1 = acc[ai][0][m][1], y0 = acc[ai][1][m][0], y1 = acc[ai][1][m][1];
                    f32x4 o0, o1;
                    if (type == 0) { o0 = x0 * y0; o1 = x1 * y1; }
                    else {
                        f32x4 s0, s1;
#pragma unroll
                        for (int i = 0; i < 4; ++i) { s0[i] = sigmoidf_fast(y0[i]); s1[i] = sigmoidf_fast(y1[i]); }
                        o0 = x0 * s0; o1 = x1 * s1;
                        if (type == 2) {
#pragma unroll
                            for (int i = 0; i < 4; ++i) { s0[i] = sigmoidf_fast(x0[i]); s1[i] = sigmoidf_fast(x1[i]); }
                            o0 = o0 * s0; o1 = o1 * s1;
                        }
                    }
                    u32x4 w; w.x = cvt_pk_bf16(o0[0], o0[1]); w.y = cvt_pk_bf16(o0[2], o0[3]); w.z = cvt_pk_bf16(o1[0], o1[1]); w.w = cvt_pk_bf16(o1[2], o1[3]);
                    *(u32x4*)(base + (size_t)(row0 + ai * HALF + m * 16) * 1024) = w;
                }
        } else if (pn < 32) {
            bf16_t* base = (pn < 28 ? P + 3 * S + 256 * (pn - 24) : P + 4 * S + 256 * (pn - 28)) + cl;
#pragma unroll
            for (int ai = 0; ai < 2; ++ai)
#pragma unroll
                for (int m = 0; m < 4; ++m)
#pragma unroll
                    for (int bj = 0; bj < 2; ++bj) { const f32x4 v0 = acc[ai][bj][m][0], v1 = acc[ai][bj][m][1];
                        u32x4 w; w.x = cvt_pk_bf16(v0[0], v0[1]); w.y = cvt_pk_bf16(v0[2], v0[3]); w.z = cvt_pk_bf16(v1[0], v1[1]); w.w = cvt_pk_bf16(v1[2], v1[3]);
                        *(u32x4*)(base + (size_t)(row0 + ai * HALF + m * 16) * 1024 + bj * HALF) = w; }
        } else {
            if (wc == 0 && fq < 2) {
#pragma unroll
                for (int ai = 0; ai < 2; ++ai)
#pragma unroll
                    for (int m = 0; m < 4; ++m) { const f32x4 v0 = acc[ai][0][m][0], v1 = acc[ai][0][m][1];
                        u32x4 w; w.x = cvt_pk_bf16(v0[0], v0[1]); w.y = cvt_pk_bf16(v0[2], v0[3]); w.z = cvt_pk_bf16(v1[0], v1[1]); w.w = cvt_pk_bf16(v1[2], v1[3]);
                        *(u32x4*)(P + 5 * S + (size_t)(row0 + ai * HALF + m * 16) * 16 + 8 * fq) = w; }
            }
        }
    }
};

struct EpiUp {
    static constexpr bool PERM = true, AFTER_DRAIN = false;
    bf16_t *A, *G; int ldc;
    __device__ __forceinline__ void operator()(const f32x4 (&acc)[2][2][4][2], const Unit& u, int wr, int wc, int fr, int fq) const {
        const int row0 = u.pm * BM + wr * 64 + fr, col = 128 * u.pn + wc * 32 + 8 * fq;
#pragma unroll
        for (int ai = 0; ai < 2; ++ai)
#pragma unroll
            for (int m = 0; m < 4; ++m)
#pragma unroll
                for (int bj = 0; bj < 2; ++bj) { const f32x4 v0 = acc[ai][bj][m][0], v1 = acc[ai][bj][m][1];
                    u32x4 w; w.x = cvt_pk_bf16(v0[0], v0[1]); w.y = cvt_pk_bf16(v0[2], v0[3]); w.z = cvt_pk_bf16(v1[0], v1[1]); w.w = cvt_pk_bf16(v1[2], v1[3]);
                    *(u32x4*)((bj == 0 ? A : G) + (size_t)(row0 + ai * HALF + m * 16) * ldc + col) = w; }
    }
};

template <class Epi, class Sched, bool ALIGN_EPI = false, bool SP2 = false>
__device__ __forceinline__ void gemm_phase(PG8_LAS unsigned char* lds, const Gemm g, const Sched& S, const Epi& E) {
    const int tid = threadIdx.x, wid = __builtin_amdgcn_readfirstlane(tid >> 6), lane = tid & 63, wr = wid >> 2, wc = wid & 3, fr = lane & 15, fq = lane >> 4;
    const int K = g.K, nt = K / BK;
    unsigned voffA[2], voffB[2];
#pragma unroll
    for (int i = 0; i < 2; ++i) { int R, C; stage_rc(tid * 16 + i * 8192, R, C); const int Rb = Epi::PERM ? ((R & ~31) + perm32(R & 31)) : R;
        voffA[i] = (unsigned)(R * K + C) * 2u; voffB[i] = (unsigned)(Rb * K + C) * 2u; }
    const size_t kstep = (size_t)(BK * 2);
    const size_t hstep = (size_t)HALF * K * 2;
    const size_t tstep = 2 * hstep;
    const unsigned ldsw = (unsigned)wid * 1024u;
    const int aoff = lds_byte(wr * 64 + fr, fq * 8), boff = lds_byte(wc * 32 + fr, fq * 8);
#define PG8_SA(b, h) (((b) * 2 + (h)) * HTB)
#define PG8_SB(b, h) ((4 + (b) * 2 + (h)) * HTB)
#define PG8_STAGE(bufoff, gbase, voff) do { _Pragma("unroll") for (int _i = 0; _i < 2; ++_i) \
        __builtin_amdgcn_global_load_lds((const unsigned*)((const char*)(gbase) + (voff)[_i]), (PG8_LAS unsigned*)(lds + (bufoff) + ldsw + _i * 8192), 16, 0, 0); } while (0)
#define PG8_LDA(dst, b, h) do { _Pragma("unroll") for (int m = 0; m < 4; ++m) _Pragma("unroll") for (int k = 0; k < 2; ++k) dst[m][k] = *(const PG8_LAS bf16x8*)(lds + PG8_SA(b, h) + aoff + m * 2048 + k * 1024); } while (0)
#define PG8_LDB(dst, b, h) do { _Pragma("unroll") for (int n = 0; n < 2; ++n) _Pragma("unroll") for (int k = 0; k < 2; ++k) dst[n][k] = *(const PG8_LAS bf16x8*)(lds + PG8_SB(b, h) + boff + n * 2048 + k * 1024); } while (0)
#define PG8_MMA(ai, bj, At, Bt) do { __builtin_amdgcn_s_setprio(1); _Pragma("unroll") for (int m = 0; m < 4; ++m) _Pragma("unroll") for (int n = 0; n < 2; ++n) _Pragma("unroll") for (int k = 0; k < 2; ++k) \
        acc[ai][bj][m][n] = __builtin_amdgcn_mfma_f32_16x16x32_bf16(Bt[n][k], At[m][k], acc[ai][bj][m][n], 0, 0, 0); __builtin_amdgcn_s_setprio(0); } while (0)
#define PG8_WAIT_V(n) asm volatile("s_waitcnt vmcnt(" #n ")" ::: "memory")
#define PG8_WAIT_L(n) asm volatile("s_waitcnt lgkmcnt(" #n ")" ::: "memory")
#define PG8_BAR __builtin_amdgcn_s_barrier()
#define PG8_SCHED __builtin_amdgcn_sched_barrier(0)
    Unit cur, nxt; int ui = 0;
    if (!S.next(0, cur)) return;
    f32x4 acc[2][2][4][2];
#pragma unroll
    for (int a = 0; a < 2; ++a)
#pragma unroll
        for (int b = 0; b < 2; ++b)
#pragma unroll
            for (int m = 0; m < 4; ++m)
#pragma unroll
                for (int n = 0; n < 2; ++n) acc[a][b][m][n] = (f32x4){0.f, 0.f, 0.f, 0.f};
    bf16x8 At[4][2], B0[2][2], B1[2][2];
    const char* cA = (const char*)g.A + (size_t)cur.pm * tstep; const char* cB = (const char*)g.Bt + (size_t)cur.pn * tstep;
    S.a_ready(cur);
    if constexpr (SP2) {
        PG8_STAGE(PG8_SB(0, 0), cB, voffB); PG8_STAGE(PG8_SB(0, 1), cB + hstep, voffB); PG8_STAGE(PG8_SA(0, 0), cA, voffA); PG8_STAGE(PG8_SA(0, 1), cA + hstep, voffA);
        if (wr == 1) PG8_BAR;
        PG8_WAIT_V(2); PG8_BAR;
        PG8_STAGE(PG8_SB(1, 0), cB + kstep, voffB); PG8_STAGE(PG8_SA(1, 0), cA + kstep, voffA); PG8_STAGE(PG8_SB(1, 1), cB + hstep + kstep, voffB);
        PG8_WAIT_V(6); PG8_BAR;
    } else {
        PG8_STAGE(PG8_SB(0, 0), cB, voffB); PG8_STAGE(PG8_SA(0, 0), cA, voffA); PG8_STAGE(PG8_SB(0, 1), cB + hstep, voffB); PG8_STAGE(PG8_SA(0, 1), cA + hstep, voffA);
        if (wr == 1) PG8_BAR;
        PG8_WAIT_V(4); PG8_BAR;
        PG8_STAGE(PG8_SB(1, 0), cB + kstep, voffB); PG8_STAGE(PG8_SA(1, 0), cA + kstep, voffA); PG8_STAGE(PG8_SB(1, 1), cB + hstep + kstep, voffB);
        PG8_WAIT_V(6); PG8_BAR;
    }
    for (;;) {
        const bool has_next = S.next(ui + 1, nxt);
        const char* nA = has_next ? (const char*)g.A + (size_t)nxt.pm * tstep : cA; const char* nB = has_next ? (const char*)g.Bt + (size_t)nxt.pn * tstep : cB;
        for (int t = 0; t < nt; t += 2) {
            const bool last = (t == nt - 2);
            const char* a1 = cA + (size_t)(t + 1) * kstep;
            const char* a2 = last ? nA : cA + (size_t)(t + 2) * kstep; const char* b2 = last ? nB : cB + (size_t)(t + 2) * kstep;
            const char* a3 = a2 + kstep; const char* b3 = b2 + kstep;
            if (last && has_next) S.a_ready(nxt);
            if constexpr (SP2) {
            PG8_LDB(B0, 0, 0); PG8_LDB(B1, 0, 1); PG8_SCHED; PG8_LDA(At, 0, 0); PG8_STAGE(PG8_SA(1, 1), a1 + hstep, voffA);
            PG8_WAIT_V(8); PG8_WAIT_L(0); PG8_BAR; PG8_MMA(0, 0, At, B0); PG8_MMA(0, 1, At, B1); PG8_BAR; PG8_SCHED;
            PG8_LDA(At, 0, 1); PG8_STAGE(PG8_SB(0, 0), b2, voffB); PG8_STAGE(PG8_SB(0, 1), b2 + hstep, voffB); PG8_STAGE(PG8_SA(0, 0), a2, voffA);
            PG8_WAIT_V(8); PG8_WAIT_L(0); PG8_BAR; PG8_MMA(1, 0, At, B0); PG8_MMA(1, 1, At, B1); PG8_BAR; PG8_SCHED;
            PG8_LDB(B0, 1, 0); PG8_LDB(B1, 1, 1); PG8_SCHED; PG8_LDA(At, 1, 0); PG8_STAGE(PG8_SA(0, 1), a2 + hstep, voffA);
            PG8_WAIT_V(8); PG8_WAIT_L(0); PG8_BAR; PG8_MMA(0, 0, At, B0); PG8_MMA(0, 1, At, B1); PG8_BAR; PG8_SCHED;
            PG8_LDA(At, 1, 1); PG8_STAGE(PG8_SB(1, 0), b3, voffB); PG8_STAGE(PG8_SB(1, 1), b3 + hstep, voffB); PG8_STAGE(PG8_SA(1, 0), a3, voffA);
            PG8_WAIT_V(8); PG8_WAIT_L(0); PG8_BAR; PG8_MMA(1, 0, At, B0); PG8_MMA(1, 1, At, B1); PG8_BAR; PG8_SCHED;
            } else {
            PG8_LDB(B0, 0, 0); PG8_SCHED; PG8_LDA(At, 0, 0); PG8_STAGE(PG8_SA(1, 1), a1 + hstep, voffA);
            PG8_WAIT_L(8); PG8_BAR; PG8_WAIT_L(0); PG8_MMA(0, 0, At, B0); PG8_BAR; PG8_SCHED;
            PG8_LDB(B1, 0, 1); PG8_STAGE(PG8_SB(0, 0), b2, voffB);
            PG8_BAR; PG8_WAIT_L(0); PG8_MMA(0, 1, At, B1); PG8_BAR;
            PG8_LDA(At, 0, 1); PG8_STAGE(PG8_SA(0, 0), a2, voffA);
            PG8_BAR; PG8_WAIT_L(0); PG8_MMA(1, 0, At, B0); PG8_BAR; PG8_SCHED;
            PG8_STAGE(PG8_SB(0, 1), b2 + hstep, voffB);
            PG8_WAIT_V(6); PG8_BAR; PG8_MMA(1, 1, At, B1); PG8_BAR;
            PG8_LDB(B0, 1, 0); PG8_SCHED; PG8_LDA(At, 1, 0); PG8_STAGE(PG8_SA(0, 1), a2 + hstep, voffA);
            PG8_WAIT_L(8); PG8_BAR; PG8_WAIT_L(0); PG8_MMA(0, 0, At, B0); PG8_BAR; PG8_SCHED;
            PG8_LDB(B1, 1, 1); PG8_STAGE(PG8_SB(1, 0), b3, voffB);
            PG8_BAR; PG8_WAIT_L(0); PG8_MMA(0, 1, At, B1); PG8_BAR;
            PG8_LDA(At, 1, 1); PG8_STAGE(PG8_SA(1, 0), a3, voffA);
            PG8_BAR; PG8_WAIT_L(0); PG8_MMA(1, 0, At, B0); PG8_BAR; PG8_SCHED;
            PG8_STAGE(PG8_SB(1, 1), b3 + hstep, voffB);
            PG8_WAIT_V(6); PG8_BAR; PG8_MMA(1, 1, At, B1); PG8_BAR;
            }
        }
        if constexpr (ALIGN_EPI) { if (wr == 0) PG8_BAR; }
        if constexpr (!Epi::AFTER_DRAIN) { E(acc, cur, wr, wc, fr, fq); S.done(cur); }
        if (!has_next) break;
#pragma unroll
        for (int a = 0; a < 2; ++a)
#pragma unroll
            for (int b = 0; b < 2; ++b)
#pragma unroll
                for (int m = 0; m < 4; ++m)
#pragma unroll
                    for (int n = 0; n < 2; ++n) acc[a][b][m][n] = (f32x4){0.f, 0.f, 0.f, 0.f};
        cur = nxt; cA = nA; cB = nB; ++ui;
        if constexpr (ALIGN_EPI) { if (wr == 1) PG8_BAR; }
    }
    PG8_WAIT_V(0);
    if constexpr (!ALIGN_EPI) { if (wr == 0) PG8_BAR; }
    PG8_BAR;
    if constexpr (Epi::AFTER_DRAIN) { E.fused(acc, cur, wr, wc, fr, fq, lds, wid, lane); S.done(cur); }
#undef PG8_SA
#undef PG8_SB
#undef PG8_STAGE
#undef PG8_LDA
#undef PG8_LDB
#undef PG8_MMA
#undef PG8_WAIT_V
#undef PG8_WAIT_L
#undef PG8_BAR
#undef PG8_SCHED
}
}
#define GAS __attribute__((address_space(1)))
#define LAS __attribute__((address_space(3)))
typedef unsigned short bf16;
typedef unsigned v4u __attribute__((ext_vector_type(4)));
typedef float f32x4 __attribute__((ext_vector_type(4)));
typedef short bf16x8 __attribute__((ext_vector_type(8)));
typedef GAS unsigned gu32;
typedef GAS unsigned long long gu64;
#define RLX_AGENT __ATOMIC_RELAXED, __HIP_MEMORY_SCOPE_AGENT
#define LDS_WAIT() asm volatile("s_waitcnt lgkmcnt(0)" ::: "memory")
#define VM_WAIT() asm volatile("s_waitcnt vmcnt(0)" ::: "memory")
__device__ __forceinline__ unsigned long long rt() { return __builtin_amdgcn_s_memrealtime(); }
__device__ __forceinline__ unsigned f2bf(float f) { unsigned u = __builtin_bit_cast(unsigned, f); return (u + 0x7fffu + ((u >> 16) & 1u)) >> 16; }
__device__ __forceinline__ unsigned pk2(float lo, float hi) { return f2bf(lo) | (f2bf(hi) << 16); }

#define XB_TMO      128
#define XB_XCNT(j)  (256  + 64 * (j))
#define XB_XSUB(j)  (1280 + 64 * (j))
#define XB_XGEN(j)  (2304 + 64 * (j))
#define XB_TOP      3328
#define XB_TOPGEN   3392
#define XCD_BAR_WORDS 3456
#define XB_SPIN_CAP (1u << 18)

__device__ __forceinline__ unsigned xb_ld(unsigned* p)              { return __hip_atomic_load(p, __ATOMIC_RELAXED, __HIP_MEMORY_SCOPE_AGENT); }
__device__ __forceinline__ unsigned xb_add(unsigned* p, unsigned v) { return __hip_atomic_fetch_add(p, v, __ATOMIC_RELAXED, __HIP_MEMORY_SCOPE_AGENT); }
__device__ __forceinline__ unsigned xb_xcc_id() { return (unsigned)__builtin_amdgcn_s_getreg((3 << 11) | 20) & 0xFu; }
#define XB_SPIN(cond, bar) do { unsigned _sp = 0; while (cond) { __builtin_amdgcn_s_sleep(1); \
    if ((++_sp & 255u) == 0u) { if (xb_ld(&(bar)[XB_TMO])) break; if (_sp > XB_SPIN_CAP) { atomicAdd(&(bar)[XB_TMO], 1u); break; } } } } while (0)

struct XcdBarrier {
    unsigned* bar; unsigned x;
    volatile LAS unsigned* st;
};

__device__ __forceinline__ XcdBarrier xcd_barrier_post(unsigned* bar, volatile LAS unsigned* st) {
    XcdBarrier b; b.bar = bar; b.x = xb_xcc_id(); b.st = st;
    if (threadIdx.x == 0) (void)xb_add(&bar[XB_XCNT(b.x)], 1u);
    return b;
}
__device__ __forceinline__ void xcd_barrier_complete(unsigned* bar, unsigned x, unsigned& nloc, unsigned& nx) {
    const unsigned G = gridDim.x * gridDim.y * gridDim.z;
    unsigned sum, cnt, mine, sp = 0u;
    for (;;) {
        sum = 0u; cnt = 0u; mine = 0u;
#pragma unroll
        for (unsigned j = 0; j < 16; ++j) { const unsigned c = xb_ld(&bar[XB_XCNT(j)]); sum += c; cnt += (c > 0u) ? 1u : 0u; mine = (j == x) ? c : mine; }
        if (sum == G) break;
        __builtin_amdgcn_s_sleep(1);
        if ((++sp & 255u) == 0u) { if (xb_ld(&bar[XB_TMO])) break; if (sp > XB_SPIN_CAP) { atomicAdd(&bar[XB_TMO], 1u); break; } }
    }
    nloc = mine > 0u ? mine : 1u; nx = cnt > 0u ? cnt : 1u;
}

__device__ __forceinline__ void xcd_barrier(const XcdBarrier& b) {
    asm volatile("s_waitcnt vmcnt(0)" ::: "memory");
    __syncthreads();
    if (threadIdx.x == 0) {
        unsigned* bar = b.bar;
        __builtin_amdgcn_s_waitcnt(0);
        unsigned nloc = b.st[0], nx = b.st[1];
        if (nloc == 0u) { xcd_barrier_complete(bar, b.x, nloc, nx); b.st[0] = nloc; b.st[1] = nx; }
        const unsigned old = xb_add(&bar[XB_XSUB(b.x)], 1u);
        const unsigned gen = old / nloc;
        if (old + 1u == (gen + 1u) * nloc) {
            __builtin_amdgcn_fence(__ATOMIC_RELEASE, "agent");
            asm volatile("s_waitcnt vmcnt(0)" ::: "memory");
            const unsigned og = xb_add(&bar[XB_TOP], 1u);
            const unsigned tg = og / nx;
            if (og + 1u == (tg + 1u) * nx) xb_add(&bar[XB_TOPGEN], 1u);
            else XB_SPIN(xb_ld(&bar[XB_TOPGEN]) == tg, bar);
            __builtin_amdgcn_fence(__ATOMIC_ACQUIRE, "agent");
            xb_add(&bar[XB_XGEN(b.x)], 1u);
            asm volatile("s_waitcnt vmcnt(0)" ::: "memory");
        } else {
            XB_SPIN(xb_ld(&bar[XB_XGEN(b.x)]) == gen, bar);
            __builtin_amdgcn_fence(__ATOMIC_ACQUIRE, "agent");
            asm volatile("s_waitcnt vmcnt(0)" ::: "memory");
        }
    }
    __syncthreads();
}

constexpr int NWAVES = 8, NTHR = 512;
constexpr int DM = 1024, MP = 16384, MSMP = 1024, MT = MP + MSMP, NBP = 8, NBS = 128, NMB = NBP + NBS, SEQ = 2048, DSEQ = 8;
constexpr int NINSRC = 8208, NIN = 8448, DFF = 2816, NUP = 2 * DFF, NADA = 6 * DM;
constexpr int NCHUNK = MP / 16 + NBS;
constexpr float EPS = 1e-6f;
constexpr size_t O_Y = 0, O_CMP = 17825792, O_GLP = 17842176, O_CFP = 18890752, O_CMS = 18935808, O_GLS = 19197952, O_CFS = 35975168, O_END = 36696064;
constexpr size_t MiB = 1u << 20;
constexpr size_t WS_CTL = 0, CTL_ZERO_BYTES = 1 * MiB;
constexpr size_t WS_MOD = 1 * MiB, WS_WOUT = 5 * MiB, WS_WUP = 7 * MiB, WS_WDOWN = 18 * MiB, WS_WIN = 24 * MiB, WS_KT = 24 * MiB;
constexpr size_t WS_H = 42 * MiB, WS_UA = 76 * MiB, WS_FA = 110 * MiB, WS_RG = 144 * MiB, WS_QK = 178 * MiB, WS_V = 212 * MiB, WS_LR = 246 * MiB, WS_DEC = 247 * MiB, WS_SSQ = 250 * MiB;
constexpr size_t WS_Y1 = 76 * MiB, WS_H2 = 24 * MiB;
constexpr size_t WS_A = 58 * MiB, WS_G = WS_A + (size_t)MT * DFF * 2, WS_F = 58 * MiB, WS_END = 256 * MiB;
static_assert(WS_G + (size_t)MT * DFF * 2 <= WS_END && WS_SSQ + (size_t)MT * 4 * 8 * 4 <= WS_END && WS_KT + (size_t)NCHUNK * 512 * 32 <= WS_H && WS_WIN + (size_t)NIN * DM * 2 <= WS_H, "ws map");
constexpr int CW_BAR = 4096;
constexpr int RING_OFF = 0, RING_BYTES = 131072, LDSCTL_OFF = RING_BYTES, MISC_OFF = LDSCTL_OFF + 320, LDS_BYTES = 147456;

typedef short s16x4 __attribute__((ext_vector_type(4)));
typedef unsigned u32x2 __attribute__((ext_vector_type(2)));
typedef float f32x2v __attribute__((ext_vector_type(2)));
__device__ __forceinline__ float bf2f(unsigned short b) { return __uint_as_float(((unsigned)b) << 16); }
__device__ __forceinline__ float bflo(unsigned w) { return __uint_as_float(w << 16); }
__device__ __forceinline__ float bfhi(unsigned w) { return __uint_as_float(w & 0xffff0000u); }
__device__ __forceinline__ unsigned cvtpk(float lo, float hi) { return pg8::cvt_pk_bf16(lo, hi); }
__device__ __forceinline__ float wave_sum(float v) {
#pragma unroll
    for (int o = 1; o < 64; o <<= 1) v += __shfl_xor(v, o);
    return v;
}
__device__ __forceinline__ float row16_sum(float v) {
    v += __int_as_float(__builtin_amdgcn_update_dpp(0, __float_as_int(v), 0x128, 0xf, 0xf, false));
    v += __int_as_float(__builtin_amdgcn_update_dpp(0, __float_as_int(v), 0x124, 0xf, 0xf, false));
    v += __int_as_float(__builtin_amdgcn_update_dpp(0, __float_as_int(v), 0x122, 0xf, 0xf, false));
    v += __int_as_float(__builtin_amdgcn_update_dpp(0, __float_as_int(v), 0x121, 0xf, 0xf, false));
    return v;
}
__device__ __forceinline__ const float* xrow_ptr(const float* xp, const float* xs, int m) { return m < MP ? xp + (size_t)m * DM : xs + (size_t)(m - MP) * DM; }
__device__ __forceinline__ int row_mb(int m) { return m < MP ? (m >> 11) : NBP + ((m - MP) >> 3); }

__device__ __forceinline__ void ada_unit(const float* cp, const float* cs, const float* w_ada, const float* b_ada, float* MOD, LAS unsigned char* lds, int nu, int tid) {
    const int lane = tid & 63, w = tid >> 6, nt = w & 1, ks = w >> 1, g = lane >> 4, c16 = lane & 15;
    const int ncol = nu * 32 + nt * 16 + c16;
    f32x4 acc[9];
#pragma unroll
    for (int i = 0; i < 9; ++i) acc[i] = (f32x4){0.f, 0.f, 0.f, 0.f};
#pragma unroll 1
    for (int q = 0; q < 4; ++q) {
        float wv[2][8];
#pragma unroll
        for (int s = 0; s < 2; ++s)
#pragma unroll
            for (int j = 0; j < 8; ++j) wv[s][j] = w_ada[(size_t)(q * 256 + ks * 64 + s * 32 + 8 * g + j) * NADA + ncol];
        __syncthreads();
#pragma unroll 1
        for (int i0 = 0; i0 < 72; i0 += 12) {
            float cvv[12];
#pragma unroll
            for (int i = 0; i < 12; ++i) { const int e = (i0 + i) * NTHR + tid, mb = e >> 8, kk = e & 255;
                const float* src = mb < NBP ? cp + mb * DM : cs + ((mb < NMB ? mb : NBP) - NBP) * DM; cvv[i] = src[q * 256 + kk]; }
#pragma unroll
            for (int i = 0; i < 12; ++i) { const int e = (i0 + i) * NTHR + tid, mb = e >> 8, kk = e & 255;
                const float cv = mb < NMB ? cvv[i] : 0.f; const float sv = cv * __builtin_amdgcn_rcpf(1.0f + __expf(-cv));
                *(LAS unsigned short*)(lds + mb * 528 + kk * 2) = (unsigned short)f2bf(sv); }
        }
        __syncthreads();
#pragma unroll
        for (int s = 0; s < 2; ++s) {
            v4u bw; bw.x = cvtpk(wv[s][0], wv[s][1]); bw.y = cvtpk(wv[s][2], wv[s][3]); bw.z = cvtpk(wv[s][4], wv[s][5]); bw.w = cvtpk(wv[s][6], wv[s][7]);
            const bf16x8 B = __builtin_bit_cast(bf16x8, bw);
            const int kcol = ks * 64 + s * 32 + 8 * g;
#pragma unroll
            for (int mt = 0; mt < 9; ++mt) { const bf16x8 A = *(const LAS bf16x8*)(lds + (16 * mt + c16) * 528 + kcol * 2);
                acc[mt] = __builtin_amdgcn_mfma_f32_16x16x32_bf16(A, B, acc[mt], 0, 0, 0); }
        }
    }
    __syncthreads();
    LAS float* red = (LAS float*)lds;
#pragma unroll
    for (int mt = 0; mt < 9; ++mt)
#pragma unroll
        for (int r = 0; r < 4; ++r) red[(w * 144 + 16 * mt + 4 * g + r) * 16 + c16] = acc[mt][r];
    __syncthreads();
    for (int i = 0; i < 9; ++i) { const int e = i * NTHR + tid, mb = e >> 5, col = e & 31, nt2 = col >> 4, c = col & 15;
        float s = 0.f;
#pragma unroll
        for (int k4 = 0; k4 < 4; ++k4) s += red[((k4 * 2 + nt2) * 144 + mb) * 16 + c];
        if (mb < NMB) MOD[(size_t)mb * NADA + nu * 32 + col] = s + b_ada[nu * 32 + col]; }
    __syncthreads();
}
__device__ __forceinline__ void transpose_item(const float* W, int N, int k0, int src0, int valid, bf16* dst, int K, LAS float* scr, int lane) {
    float tv[32];
#pragma unroll
    for (int i = 0; i < 32; ++i) { const int kk = 2 * i + (lane >> 5), cl = lane & 31; tv[i] = cl < valid ? W[(size_t)(k0 + kk) * N + src0 + cl] : 0.f; }
#pragma unroll
    for (int i = 0; i < 32; ++i) { const int kk = 2 * i + (lane >> 5), cl = lane & 31; scr[kk * 33 + cl] = tv[i]; }
    LDS_WAIT(); asm volatile("" ::: "memory");
    const int c = lane & 7;
#pragma unroll
    for (int j = 0; j < 4; ++j) { const int n = (lane >> 3) + 8 * j; const LAS float* s = scr + (8 * c) * 33 + n;
        v4u o; o.x = cvtpk(s[0 * 33], s[1 * 33]); o.y = cvtpk(s[2 * 33], s[3 * 33]); o.z = cvtpk(s[4 * 33], s[5 * 33]); o.w = cvtpk(s[6 * 33], s[7 * 33]);
        *(v4u*)(dst + (size_t)n * K + k0 + 8 * c) = o; }
    LDS_WAIT(); asm volatile("" ::: "memory");
}
__device__ __forceinline__ void win_map(int nb, int& src, int& valid) {
    const int n = nb * 32, pn = n >> 8, c = n & 255, half = c >> 7, cc = c & 127; valid = 32;
    if (pn < 8) src = (half ? 2048 : 1024) + 128 * pn + cc;
    else if (pn < 16) src = (half ? 6160 : 0) + 128 * (pn - 8) + cc;
    else if (pn < 24) src = (half ? 7184 : 5120) + 128 * (pn - 16) + cc;
    else if (pn < 26) src = 3072 + 256 * (pn - 24) + c;
    else if (pn < 28) src = 3584 + 256 * (pn - 26) + c;
    else if (pn < 32) src = 4096 + 256 * (pn - 28) + c;
    else { src = 6144; valid = (c == 0) ? 16 : 0; }
}

struct Args { const float* in[24]; float* out; unsigned char* ws; int ph_lo, ph_hi; };
constexpr int N_PHASES = 12;

__global__ void __launch_bounds__(NTHR, 2) mk_fwd(Args args) {
    extern __shared__ __attribute__((aligned(16))) unsigned char lds_raw[];
    LAS unsigned char* lds = (LAS unsigned char*)lds_raw;
    volatile LAS unsigned* MISC = (volatile LAS unsigned*)(lds + MISC_OFF);
    const int tid = threadIdx.x, lane = tid & 63, wave = __builtin_amdgcn_readfirstlane(tid >> 6);
    const int G = gridDim.x, bx = blockIdx.x;
    const int vcu = (G % 8 == 0) ? (bx % 8) * (G / 8) + bx / 8 : bx;
    const int gw = vcu * NWAVES + wave, NGW = G * NWAVES;
#define ws (args.ws)
#define out (args.out)
#define x_p (args.in[0])
#define x_s (args.in[1])
#define c_p (args.in[2])
#define c_s (args.in[3])
#define st_cm (args.in[4])
#define st_gla (args.in[5])
#define st_cf (args.in[6])
#define w_ada (args.in[7])
#define b_ada (args.in[8])
#define n_pre1 (args.in[9])
#define n_post1 (args.in[10])
#define n_pre2 (args.in[11])
#define n_post2 (args.in[12])
#define w_in (args.in[13])
#define conv_w (args.in[14])
#define conv_b (args.in[15])
#define w_a2 (args.in[16])
#define b_a (args.in[17])
#define gla_norm (args.in[18])
#define w_out (args.in[19])
#define w_up (args.in[20])
#define fconv_w (args.in[21])
#define fconv_b (args.in[22])
#define w_down (args.in[23])
#define ctl ((gu32*)(ws + WS_CTL))
#define MOD ((float*)(ws + WS_MOD))
#define WIN_T ((bf16*)(ws + WS_WIN))
#define WOUT_T ((bf16*)(ws + WS_WOUT))
#define WUP_T ((bf16*)(ws + WS_WUP))
#define WDOWN_T ((bf16*)(ws + WS_WDOWN))
#define HB ((bf16*)(ws + WS_H))
#define UA ((bf16*)(ws + WS_UA))
#define FA ((bf16*)(ws + WS_FA))
#define RG ((bf16*)(ws + WS_RG))
#define QK ((bf16*)(ws + WS_QK))
#define VB ((bf16*)(ws + WS_V))
#define LR ((bf16*)(ws + WS_LR))
#define KT ((bf16*)(ws + WS_KT))
#define DEC ((float*)(ws + WS_DEC))
#define SSQ ((float*)(ws + WS_SSQ))
#define ORAW ((bf16*)(out + O_Y))
#define Y1 ((float*)(ws + WS_Y1))
#define H2 ((bf16*)(ws + WS_H2))
#define AB ((bf16*)(ws + WS_A))
#define GB ((bf16*)(ws + WS_G))
#define FB ((float*)(ws + WS_F))
    for (int u = tid; u < (LDS_BYTES - LDSCTL_OFF) / 4; u += NTHR) ((LAS unsigned*)(lds + LDSCTL_OFF))[u] = 0u;
    __syncthreads();
    const int lo = args.ph_lo, hi = args.ph_hi;
    const bool multi = (hi - lo) > 1;
    XcdBarrier bar; bar.bar = (unsigned*)(ctl + CW_BAR); bar.x = 0; bar.st = nullptr;
    if (multi) bar = xcd_barrier_post((unsigned*)(ctl + CW_BAR), MISC + 8);
#ifndef PH_MASK
#define PH_MASK 0xfff
#endif
#define IN(k) ((((PH_MASK) >> (k)) & 1) && lo <= (k) && (k) < hi)
#define SEAM(k) do { if (IN(k) && IN((k) + 1)) xcd_barrier(bar); } while (0)
#ifndef REPEAT_MASK
#define REPEAT_MASK 0
#endif
#define NREP(k) ((((REPEAT_MASK) >> (k)) & 1) ? 2 : 1)

    if (IN(0)) for (int rep_ = 0; rep_ < NREP(0); ++rep_) { if (rep_) xcd_barrier(bar);
        for (int nu = bx; nu < NADA / 32; nu += G) ada_unit(c_p, c_s, w_ada, b_ada, MOD, lds, nu, tid);
        LAS float* scr = (LAS float*)(lds + wave * 16384);
        constexpr int I_IN = 16 * (NIN / 32), I_OUT = 16 * (DM / 32), I_UP = 16 * (NUP / 32), I_DOWN = (DFF / 64) * (DM / 32), NITEMS = I_IN + I_OUT + I_UP + I_DOWN;
        for (int it = NGW - 1 - gw; it < NITEMS; it += NGW) {
            int r = it;
            if (r < I_IN) { const int kb = r / (NIN / 32), nb = r % (NIN / 32); int src, valid; win_map(nb, src, valid);
                transpose_item(w_in, NINSRC, 64 * kb, src, valid, WIN_T + (size_t)nb * 32 * DM, DM, scr, lane); continue; } r -= I_IN;
            if (r < I_OUT) { const int kb = r / (DM / 32), nb = r % (DM / 32);
                transpose_item(w_out, DM, 64 * kb, 32 * nb, 32, WOUT_T + (size_t)nb * 32 * DM, DM, scr, lane); continue; } r -= I_OUT;
            if (r < I_UP) { const int kb = r / (NUP / 32), nb = r % (NUP / 32); const int n = nb * 32, pn = n >> 8, c = n & 255;
                const int src = (c < 128) ? 128 * pn + c : DFF + 128 * pn + (c - 128);
                transpose_item(w_up, NUP, 64 * kb, src, 32, WUP_T + (size_t)nb * 32 * DM, DM, scr, lane); continue; } r -= I_UP;
            { const int kb = r / (DM / 32), nb = r % (DM / 32);
                transpose_item(w_down, DM, 64 * kb, 32 * nb, 32, WDOWN_T + (size_t)nb * 32 * DFF, DFF, scr, lane); }
        }
    }
    SEAM(0);
    if (IN(1)) for (int rep_ = 0; rep_ < NREP(1); ++rep_) { if (rep_) xcd_barrier(bar);
        for (int m = gw; m < MT; m += NGW) {
            const f32x4* xr = (const f32x4*)xrow_ptr(x_p, x_s, m) + lane; const int mb = row_mb(m);
            const f32x4* sh = (const f32x4*)(MOD + (size_t)mb * NADA) + lane; const f32x4* sc = (const f32x4*)(MOD + (size_t)mb * NADA + DM) + lane; const f32x4* gp = (const f32x4*)n_pre1 + lane;
            f32x4 v[4]; float s = 0.f;
#pragma unroll
            for (int j = 0; j < 4; ++j) { v[j] = xr[64 * j]; s += (v[j].x * v[j].x + v[j].y * v[j].y) + (v[j].z * v[j].z + v[j].w * v[j].w); }
            const float rstd = rsqrtf(wave_sum(s) * (1.f / DM) + EPS);
            u32x2* o8 = (u32x2*)(HB + (size_t)m * DM) + lane;
#pragma unroll
            for (int j = 0; j < 4; ++j) { const f32x4 g4 = gp[64 * j], c4 = sc[64 * j], h4 = sh[64 * j]; const f32x4 o = (v[j] * rstd) * g4 * (c4 + 1.0f) + h4;
                u32x2 w; w.x = cvtpk(o.x, o.y); w.y = cvtpk(o.z, o.w); o8[64 * j] = w; }
        }
    }
    SEAM(1);
    if (IN(2)) for (int rep_ = 0; rep_ < NREP(2); ++rep_) { if (rep_) xcd_barrier(bar);
        pg8::Gemm g{HB, WIN_T, MT, NIN, DM}; pg8::StaticOrder S; S.init(MT, NIN, G, bx);
        pg8::EpiProj E{UA, (size_t)(WS_FA - WS_UA) / 2};
        static_assert(WS_RG - WS_UA == 2 * (WS_FA - WS_UA) && WS_QK - WS_UA == 3 * (WS_FA - WS_UA) && WS_V - WS_UA == 4 * (WS_FA - WS_UA) && WS_LR - WS_UA == 5 * (WS_FA - WS_UA), "proj map");
        pg8::gemm_phase<pg8::EpiProj, pg8::StaticOrder, true, true>(lds + RING_OFF, g, S, E);
    }
    SEAM(2);
    if (IN(3)) {
        const int col = tid;
        float wa[16];
#pragma unroll
        for (int r = 0; r < 16; ++r) wa[r] = w_a2[r * 512 + col];
        const float ba = b_a[col];
        for (int chunk = vcu; chunk < NCHUNK; chunk += G) {
            const bool smp = chunk >= MP / 16; const int row0 = smp ? MP + (chunk - MP / 16) * DSEQ : chunk * 16; const int T = smp ? DSEQ : 16;
            float bcum[16]; float bc = 0.f;
#pragma unroll
            for (int t = 0; t < 16; ++t) { bcum[t] = 0.f;
                if (t < T) { const v4u l0 = *(const v4u*)(LR + (size_t)(row0 + t) * 16), l1 = *(const v4u*)(LR + (size_t)(row0 + t) * 16 + 8);
                    float xv = ba;
                    xv += bflo(l0.x) * wa[0] + bfhi(l0.x) * wa[1] + bflo(l0.y) * wa[2] + bfhi(l0.y) * wa[3] + bflo(l0.z) * wa[4] + bfhi(l0.z) * wa[5] + bflo(l0.w) * wa[6] + bfhi(l0.w) * wa[7];
                    xv += bflo(l1.x) * wa[8] + bfhi(l1.x) * wa[9] + bflo(l1.y) * wa[10] + bfhi(l1.y) * wa[11] + bflo(l1.z) * wa[12] + bfhi(l1.z) * wa[13] + bflo(l1.w) * wa[14] + bfhi(l1.w) * wa[15];
                    const float ls = fminf(xv, 0.f) - log1pf(__expf(-fabsf(xv)));
                    bc += ls * (1.0f / 16.0f); bcum[t] = bc; } }
            const float blast = bc;
            float kh[16];
#pragma unroll
            for (int t = 0; t < 16; ++t) { kh[t] = 0.f;
                if (t < T) { bf16* qp = QK + (size_t)(row0 + t) * DM + col; const float qv = bf2f(qp[0]), kv = bf2f(qp[512]);
                    const float eq = __expf(bcum[t]);
                    qp[0] = (bf16)f2bf(qv * 0.08838834764831845f * eq); qp[512] = (bf16)f2bf(kv * __expf(-bcum[t])); kh[t] = kv * __expf(blast - bcum[t]); } }
            v4u k0, k1; k0.x = cvtpk(kh[0], kh[1]); k0.y = cvtpk(kh[2], kh[3]); k0.z = cvtpk(kh[4], kh[5]); k0.w = cvtpk(kh[6], kh[7]);
            k1.x = cvtpk(kh[8], kh[9]); k1.y = cvtpk(kh[10], kh[11]); k1.z = cvtpk(kh[12], kh[13]); k1.w = cvtpk(kh[14], kh[15]);
            v4u* kt = (v4u*)(KT + ((size_t)chunk * 512 + col) * 16); kt[0] = k0; kt[1] = k1;
            DEC[(size_t)chunk * 512 + col] = __expf(blast);
        }
    }
    SEAM(3);
    if (IN(4)) for (int rep_ = 0; rep_ < NREP(4); ++rep_) { if (rep_) xcd_barrier(bar);
        constexpr int NT = 2, NSL = 256 / (16 * NT);
        const int c16 = lane & 15, g = lane >> 4;
        constexpr int NU_P = NBP * 4 * NSL, NU_S = NBS * 4 * NSL;
        if (wave == 0) {
            constexpr int SLOT = 14336, DEPTH = 4, INFL = 3, NCH = SEQ / 16;
            for (int un = vcu; un < NU_P; un += G) {
                const int sl = un % NSL, h = (un / NSL) & 3, b = un / (NSL * 4);
                const int row_base = b * SEQ, chunk_base = b * NCH;
                const int v0 = h * 256 + sl * 16 * NT + NT * c16;
                f32x4 S[8][NT];
#pragma unroll
                for (int mt = 0; mt < 8; ++mt)
#pragma unroll
                    for (int nt = 0; nt < NT; ++nt) S[mt][nt] = (f32x4){0.f, 0.f, 0.f, 0.f};
                const char* ubq = (const char*)(QK + (size_t)row_base * DM + h * 128);
                const char* ubkt = (const char*)(KT + ((size_t)chunk_base * 512 + h * 128) * 16);
                const char* ubv = (const char*)(VB + (size_t)row_base * DM + h * 256 + sl * 32);
                const char* ubd = (const char*)(DEC + (size_t)chunk_base * 512 + h * 128);
                const unsigned voq = (unsigned)(((lane & 15) * DM + (lane >> 4) * 8) * 2), vokt = (unsigned)(lane * 16), vov = (unsigned)(((lane >> 2) * DM + (lane & 3) * 8) * 2), vod = (unsigned)((lane & 31) * 16);
#define GLDS16(gp, off) __builtin_amdgcn_global_load_lds((const unsigned*)(gp), (LAS unsigned*)(lds + (off)), 16, 0, 0)
#define CHAIN_ISSUE(cc) do { const int so_ = ((cc) % DEPTH) * SLOT; const char* q_ = ubq + (size_t)(cc) * (16 * DM * 2); const char* kt_ = ubkt + (size_t)(cc) * (512 * 32); \
        _Pragma("unroll") for (int i_ = 0; i_ < 4; ++i_) { GLDS16(q_ + i_ * 64 + voq, so_ + i_ * 1024); GLDS16(q_ + 1024 + i_ * 64 + voq, so_ + 4096 + i_ * 1024); GLDS16(kt_ + i_ * 1024 + vokt, so_ + 8192 + i_ * 1024); } \
        GLDS16(ubv + (size_t)(cc) * (16 * DM * 2) + vov, so_ + 12288); GLDS16(ubd + (size_t)(cc) * 2048 + vod, so_ + 13312); } while (0)
                asm volatile("s_waitcnt lgkmcnt(0)" ::: "memory");
                CHAIN_ISSUE(0); CHAIN_ISSUE(1); CHAIN_ISSUE(2);
                for (int c = 0; c < NCH; ++c) {
                    asm volatile("s_waitcnt lgkmcnt(0)" ::: "memory");
                    const int rem = NCH - 1 - c;
                    if (rem >= INFL) { CHAIN_ISSUE(c + INFL); asm volatile("s_waitcnt vmcnt(42)" ::: "memory"); }
                    else if (rem == 2) asm volatile("s_waitcnt vmcnt(28)" ::: "memory");
                    else if (rem == 1) asm volatile("s_waitcnt vmcnt(14)" ::: "memory");
                    else asm volatile("s_waitcnt vmcnt(0)" ::: "memory");
                    const LAS unsigned char* sb = lds + (c % DEPTH) * SLOT;
                    const int r0 = row_base + c * 16;
                    bf16x8 Qf[4], Kf[4];
#pragma unroll
                    for (int s = 0; s < 4; ++s) {
                        const int o0 = ((4 * s + (g >> 1)) * 16 + c16) * 16 + (g & 1) * 8, o1 = o0 + 2 * 256;
                        const u32x2 a0 = *(const LAS u32x2*)(sb + o0), a1 = *(const LAS u32x2*)(sb + o1), b0 = *(const LAS u32x2*)(sb + 4096 + o0), b1 = *(const LAS u32x2*)(sb + 4096 + o1);
                        Qf[s] = __builtin_bit_cast(bf16x8, (v4u){a0.x, a0.y, a1.x, a1.y}); Kf[s] = __builtin_bit_cast(bf16x8, (v4u){b0.x, b0.y, b1.x, b1.y});
                    }
                    bf16x8 KTf[8];
#pragma unroll
                    for (int mt = 0; mt < 8; ++mt) { const u32x2 kk2 = *(const LAS u32x2*)(sb + 8192 + (16 * mt + c16) * 32 + g * 8); KTf[mt] = __builtin_bit_cast(bf16x8, (v4u){kk2.x, kk2.y, 0u, 0u}); }
                    bf16x8 Vf[NT];
                    {
                        unsigned w2[4];
#pragma unroll
                        for (int j = 0; j < 4; ++j) w2[j] = *(const LAS unsigned*)(sb + 12288 + (4 * g + j) * 64 + c16 * 4);
                        Vf[0] = __builtin_bit_cast(bf16x8, (v4u){(w2[0] & 0xffffu) | (w2[1] << 16), (w2[2] & 0xffffu) | (w2[3] << 16), 0u, 0u});
                        Vf[1] = __builtin_bit_cast(bf16x8, (v4u){(w2[0] >> 16) | (w2[1] & 0xffff0000u), (w2[2] >> 16) | (w2[3] & 0xffff0000u), 0u, 0u});
                    }
                    f32x4 dec[8];
#pragma unroll
                    for (int mt = 0; mt < 8; ++mt) dec[mt] = *(const LAS f32x4*)(sb + 13312 + (16 * mt + 4 * g) * 4);
                    f32x4 PT = (f32x4){0.f, 0.f, 0.f, 0.f};
#pragma unroll
                    for (int s = 0; s < 4; ++s) PT = __builtin_amdgcn_mfma_f32_16x16x32_bf16(Kf[s], Qf[s], PT, 0, 0, 0);
#pragma unroll
                    for (int r = 0; r < 4; ++r) if (4 * g + r > c16) PT[r] = 0.f;
                    const bf16x8 Pf = __builtin_bit_cast(bf16x8, (v4u){cvtpk(PT[0], PT[1]), cvtpk(PT[2], PT[3]), 0u, 0u});
                    f32x4 o[NT];
#pragma unroll
                    for (int nt = 0; nt < NT; ++nt) {
                        o[nt] = __builtin_amdgcn_mfma_f32_16x16x32_bf16(Pf, Vf[nt], (f32x4){0.f, 0.f, 0.f, 0.f}, 0, 0, 0);
#pragma unroll
                        for (int s = 0; s < 4; ++s) {
                            const f32x4 sa = S[2 * s][nt], sb2 = S[2 * s + 1][nt];
                            const bf16x8 Sb = __builtin_bit_cast(bf16x8, (v4u){cvtpk(sa[0], sa[1]), cvtpk(sa[2], sa[3]), cvtpk(sb2[0], sb2[1]), cvtpk(sb2[2], sb2[3])});
                            o[nt] = __builtin_amdgcn_mfma_f32_16x16x32_bf16(Qf[s], Sb, o[nt], 0, 0, 0);
                        }
                    }
#pragma unroll
                    for (int mt = 0; mt < 8; ++mt)
#pragma unroll
                        for (int nt = 0; nt < NT; ++nt) S[mt][nt] = __builtin_amdgcn_mfma_f32_16x16x32_bf16(KTf[mt], Vf[nt], S[mt][nt] * dec[mt], 0, 0, 0);
#pragma unroll
                    for (int r = 0; r < 4; ++r) {
                        float ss = o[0][r] * o[0][r] + o[1][r] * o[1][r];
                        ss = row16_sum(ss);
                        const int row = r0 + 4 * g + r;
                        *(unsigned*)(ORAW + (size_t)row * DM + v0) = cvtpk(o[0][r], o[1][r]);
                        if (c16 == 0) SSQ[((size_t)row * 4 + h) * NSL + sl] = ss;
                    }
                }
#undef CHAIN_ISSUE
#undef GLDS16
                float* so = out + O_GLP + ((size_t)(b * 4 + h) * 128) * 256 + (v0 - h * 256);
#pragma unroll
                for (int mt = 0; mt < 8; ++mt)
#pragma unroll
                    for (int r = 0; r < 4; ++r) *(f32x2v*)(so + (size_t)(16 * mt + 4 * g + r) * 256) = (f32x2v){S[mt][0][r], S[mt][1][r]};
            }
        } else {
            constexpr int T = DSEQ;
#pragma unroll 1
            for (int un = (wave - 1) * G + vcu; un < NU_S; un += (NWAVES - 1) * G) {
                const int sl = un % NSL, h = (un / NSL) & 3, b = un / (NSL * 4);
                const int r0 = MP + b * DSEQ, chunk = MP / 16 + b;
                const int v0 = h * 256 + sl * 16 * NT + NT * c16;
                const float* s0 = st_gla + ((size_t)(b * 4 + h) * 128) * 256 + (v0 - h * 256);
                float* so = out + O_GLS + ((size_t)(b * 4 + h) * 128) * 256 + (v0 - h * 256);
                bf16x8 Qf[4], Kf[4];
                const bool vrow = c16 < T;
                const bf16* qrow = QK + (size_t)(r0 + (vrow ? c16 : 0)) * DM + h * 128 + 4 * g;
#pragma unroll
                for (int s = 0; s < 4; ++s) {
                    u32x2 a0 = *(const u32x2*)(qrow + 32 * s), a1 = *(const u32x2*)(qrow + 32 * s + 16), b0 = *(const u32x2*)(qrow + 512 + 32 * s), b1 = *(const u32x2*)(qrow + 512 + 32 * s + 16);
                    if (!vrow) { a0 = (u32x2){0u, 0u}; a1 = a0; b0 = a0; b1 = a0; }
                    Qf[s] = __builtin_bit_cast(bf16x8, (v4u){a0.x, a0.y, a1.x, a1.y}); Kf[s] = __builtin_bit_cast(bf16x8, (v4u){b0.x, b0.y, b1.x, b1.y});
                }
                bf16x8 Vf[NT];
                {
                    unsigned w2[4];
#pragma unroll
                    for (int j = 0; j < 4; ++j) { const bool ok = (4 * g + j) < T; w2[j] = ok ? *(const unsigned*)(VB + (size_t)(r0 + 4 * g + j) * DM + v0) : 0u; }
                    Vf[0] = __builtin_bit_cast(bf16x8, (v4u){(w2[0] & 0xffffu) | (w2[1] << 16), (w2[2] & 0xffffu) | (w2[3] << 16), 0u, 0u});
                    Vf[1] = __builtin_bit_cast(bf16x8, (v4u){(w2[0] >> 16) | (w2[1] & 0xffff0000u), (w2[2] >> 16) | (w2[3] & 0xffff0000u), 0u, 0u});
                }
                f32x4 PT = (f32x4){0.f, 0.f, 0.f, 0.f};
#pragma unroll
                for (int s = 0; s < 4; ++s) PT = __builtin_amdgcn_mfma_f32_16x16x32_bf16(Kf[s], Qf[s], PT, 0, 0, 0);
#pragma unroll
                for (int r = 0; r < 4; ++r) if (4 * g + r > c16) PT[r] = 0.f;
                const bf16x8 Pf = __builtin_bit_cast(bf16x8, (v4u){cvtpk(PT[0], PT[1]), cvtpk(PT[2], PT[3]), 0u, 0u});
                f32x4 o[NT];
#pragma unroll
                for (int nt = 0; nt < NT; ++nt) o[nt] = __builtin_amdgcn_mfma_f32_16x16x32_bf16(Pf, Vf[nt], (f32x4){0.f, 0.f, 0.f, 0.f}, 0, 0, 0);
#pragma unroll
                for (int s = 0; s < 4; ++s) {
                    f32x4 S2[2][NT]; bf16x8 KTf[2]; f32x4 dec[2];
#pragma unroll
                    for (int m2 = 0; m2 < 2; ++m2) { const int mt = 2 * s + m2;
#pragma unroll
                        for (int r = 0; r < 4; ++r) { const f32x2v t2 = *(const f32x2v*)(s0 + (size_t)(16 * mt + 4 * g + r) * 256); S2[m2][0][r] = t2.x; S2[m2][1][r] = t2.y; }
                        const u32x2 kk2 = *(const u32x2*)(KT + ((size_t)chunk * 512 + h * 128 + 16 * mt + c16) * 16 + 4 * g); KTf[m2] = __builtin_bit_cast(bf16x8, (v4u){kk2.x, kk2.y, 0u, 0u});
                        dec[m2] = *(const f32x4*)(DEC + (size_t)chunk * 512 + h * 128 + 16 * mt + 4 * g); }
#pragma unroll
                    for (int nt = 0; nt < NT; ++nt) {
                        const f32x4 sa = S2[0][nt], sb2 = S2[1][nt];
                        const bf16x8 Sb = __builtin_bit_cast(bf16x8, (v4u){cvtpk(sa[0], sa[1]), cvtpk(sa[2], sa[3]), cvtpk(sb2[0], sb2[1]), cvtpk(sb2[2], sb2[3])});
                        o[nt] = __builtin_amdgcn_mfma_f32_16x16x32_bf16(Qf[s], Sb, o[nt], 0, 0, 0);
                    }
#pragma unroll
                    for (int m2 = 0; m2 < 2; ++m2) { const int mt = 2 * s + m2;
#pragma unroll
                        for (int nt = 0; nt < NT; ++nt) S2[m2][nt] = __builtin_amdgcn_mfma_f32_16x16x32_bf16(KTf[m2], Vf[nt], S2[m2][nt] * dec[m2], 0, 0, 0);
#pragma unroll
                        for (int r = 0; r < 4; ++r) *(f32x2v*)(so + (size_t)(16 * mt + 4 * g + r) * 256) = (f32x2v){S2[m2][0][r], S2[m2][1][r]}; }
                    __builtin_amdgcn_sched_barrier(0);
                }
#pragma unroll
                for (int r = 0; r < 4; ++r) {
                    float ss = o[0][r] * o[0][r] + o[1][r] * o[1][r];
                    ss = row16_sum(ss);
                    if (4 * g + r < T) { const int row = r0 + 4 * g + r;
                        *(unsigned*)(ORAW + (size_t)row * DM + v0) = cvtpk(o[0][r], o[1][r]);
                        if (c16 == 0) SSQ[((size_t)row * 4 + h) * NSL + sl] = ss; }
                }
            }
        }
    }
    SEAM(4);
    if (IN(5)) for (int rep_ = 0; rep_ < NREP(5); ++rep_) { if (rep_) xcd_barrier(bar);
        constexpr int NSL = 8;
        const int nitems = NCHUNK * 128;
        for (int it = vcu * NTHR + tid; it < nitems; it += G * NTHR) {
            const int cg = it & 127, run = it >> 7, ch = cg * 8, h = cg >> 5;
            const bool smp = run >= MP / 16; const int row0 = smp ? MP + (run - MP / 16) * DSEQ : run * 16; const int T = smp ? DSEQ : 16;
            float w0[8], w1[8], w2[8], cb[8], gn[8];
#pragma unroll
            for (int i = 0; i < 8; ++i) { w0[i] = conv_w[ch + i]; w1[i] = conv_w[DM + ch + i]; w2[i] = conv_w[2 * DM + ch + i]; cb[i] = conv_b[ch + i]; gn[i] = gla_norm[ch + i]; }
            float um2[8], um1[8];
            if (smp) { const float* st = st_cm + (size_t)(run - MP / 16) * 2 * DM + ch;
#pragma unroll
                for (int i = 0; i < 8; ++i) { um2[i] = st[i]; um1[i] = st[DM + i]; }
            } else if ((run & 127) == 0) {
#pragma unroll
                for (int i = 0; i < 8; ++i) { um2[i] = 0.f; um1[i] = 0.f; }
            } else { const v4u a = *(const v4u*)(UA + (size_t)(row0 - 2) * DM + ch), b = *(const v4u*)(UA + (size_t)(row0 - 1) * DM + ch);
                um2[0] = bflo(a.x); um2[1] = bfhi(a.x); um2[2] = bflo(a.y); um2[3] = bfhi(a.y); um2[4] = bflo(a.z); um2[5] = bfhi(a.z); um2[6] = bflo(a.w); um2[7] = bfhi(a.w);
                um1[0] = bflo(b.x); um1[1] = bfhi(b.x); um1[2] = bflo(b.y); um1[3] = bfhi(b.y); um1[4] = bflo(b.z); um1[5] = bfhi(b.z); um1[6] = bflo(b.w); um1[7] = bfhi(b.w); }
            for (int t = 0; t < T; ++t) {
                const size_t ro = (size_t)(row0 + t) * DM + ch;
                const v4u ua = *(const v4u*)(UA + ro), fa = *(const v4u*)(FA + ro), rg = *(const v4u*)(RG + ro), ob = *(const v4u*)(ORAW + ro);
                const f32x4 s0 = *(const f32x4*)(SSQ + ((size_t)(row0 + t) * 4 + h) * NSL), s1 = *(const f32x4*)(SSQ + ((size_t)(row0 + t) * 4 + h) * NSL + 4);
                const float rs = rsqrtf(((s0.x + s0.y) + (s0.z + s0.w) + (s1.x + s1.y) + (s1.z + s1.w)) * (1.0f / 256.0f) + EPS);
                float u[8], f[8], q[8], ov[8];
                u[0] = bflo(ua.x); u[1] = bfhi(ua.x); u[2] = bflo(ua.y); u[3] = bfhi(ua.y); u[4] = bflo(ua.z); u[5] = bfhi(ua.z); u[6] = bflo(ua.w); u[7] = bfhi(ua.w);
                f[0] = bflo(fa.x); f[1] = bfhi(fa.x); f[2] = bflo(fa.y); f[3] = bfhi(fa.y); f[4] = bflo(fa.z); f[5] = bfhi(fa.z); f[6] = bflo(fa.w); f[7] = bfhi(fa.w);
                q[0] = bflo(rg.x); q[1] = bfhi(rg.x); q[2] = bflo(rg.y); q[3] = bfhi(rg.y); q[4] = bflo(rg.z); q[5] = bfhi(rg.z); q[6] = bflo(rg.w); q[7] = bfhi(rg.w);
                ov[0] = bflo(ob.x); ov[1] = bfhi(ob.x); ov[2] = bflo(ob.y); ov[3] = bfhi(ob.y); ov[4] = bflo(ob.z); ov[5] = bfhi(ob.z); ov[6] = bflo(ob.w); ov[7] = bfhi(ob.w);
                float mo[8];
#pragma unroll
                for (int i = 0; i < 8; ++i) { const float cv = cb[i] + w0[i] * um2[i] + w1[i] * um1[i] + w2[i] * u[i];
                    mo[i] = f[i] * cv + q[i] * gn[i] * ov[i] * rs; um2[i] = um1[i]; um1[i] = u[i]; }
                v4u w; w.x = cvtpk(mo[0], mo[1]); w.y = cvtpk(mo[2], mo[3]); w.z = cvtpk(mo[4], mo[5]); w.w = cvtpk(mo[6], mo[7]);
                *(v4u*)(HB + ro) = w;
            }
            if (smp || (run & 127) == 127) {
                float* cs = smp ? out + O_CMS + (size_t)(run - MP / 16) * 2 * DM + ch : out + O_CMP + (size_t)(run >> 7) * 2 * DM + ch;
#pragma unroll
                for (int i = 0; i < 8; ++i) { cs[i] = um2[i]; cs[DM + i] = um1[i]; }
            }
        }
    }
    SEAM(5);
    if (IN(6)) for (int rep_ = 0; rep_ < NREP(6); ++rep_) { if (rep_) xcd_barrier(bar);
        pg8::Gemm g{HB, WOUT_T, MT, DM, DM}; pg8::StaticOrder S; S.init(MT, DM, G, bx);
        pg8::EpiF32 E{Y1, DM};
        pg8::gemm_phase<pg8::EpiF32, pg8::StaticOrder, true, true>(lds + RING_OFF, g, S, E);
    }
    SEAM(6);
    if (IN(7)) for (int rep_ = 0; rep_ < NREP(7); ++rep_) { if (rep_) xcd_barrier(bar);
        for (int m = gw; m < MT; m += NGW) {
            const f32x4* xr = (const f32x4*)xrow_ptr(x_p, x_s, m) + lane; const f32x4* yr = (const f32x4*)(Y1 + (size_t)m * DM) + lane; const int mb = row_mb(m);
            const float* mod = MOD + (size_t)mb * NADA;
            const f32x4* g1 = (const f32x4*)(mod + 2 * DM) + lane; const f32x4* sh2 = (const f32x4*)(mod + 3 * DM) + lane; const f32x4* sc2 = (const f32x4*)(mod + 4 * DM) + lane;
            const f32x4* np1 = (const f32x4*)n_post1 + lane; const f32x4* np2 = (const f32x4*)n_pre2 + lane;
            f32x4 y[4]; float s = 0.f;
#pragma unroll
            for (int j = 0; j < 4; ++j) { y[j] = yr[64 * j]; s += (y[j].x * y[j].x + y[j].y * y[j].y) + (y[j].z * y[j].z + y[j].w * y[j].w); }
            const float rstd = rsqrtf(wave_sum(s) * (1.f / DM) + EPS);
            f32x4 x1[4]; float s2 = 0.f; f32x4* xo = (f32x4*)(out + O_Y + (size_t)m * DM) + lane;
#pragma unroll
            for (int j = 0; j < 4; ++j) { x1[j] = xr[64 * j] + g1[64 * j] * ((y[j] * rstd) * np1[64 * j]); xo[64 * j] = x1[j];
                s2 += (x1[j].x * x1[j].x + x1[j].y * x1[j].y) + (x1[j].z * x1[j].z + x1[j].w * x1[j].w); }
            const float rstd2 = rsqrtf(wave_sum(s2) * (1.f / DM) + EPS);
            u32x2* o8 = (u32x2*)(H2 + (size_t)m * DM) + lane;
#pragma unroll
            for (int j = 0; j < 4; ++j) { const f32x4 o = (x1[j] * rstd2) * np2[64 * j] * (sc2[64 * j] + 1.0f) + sh2[64 * j];
                u32x2 w; w.x = cvtpk(o.x, o.y); w.y = cvtpk(o.z, o.w); o8[64 * j] = w; }
        }
    }
    SEAM(7);
    if (IN(8)) for (int rep_ = 0; rep_ < NREP(8); ++rep_) { if (rep_) xcd_barrier(bar);
        pg8::Gemm g{H2, WUP_T, MT, NUP, DM}; pg8::StaticOrder S; S.init(MT, NUP, G, bx);
        pg8::EpiUp E{AB, GB, DFF};
        pg8::gemm_phase<pg8::EpiUp, pg8::StaticOrder, true, true>(lds + RING_OFF, g, S, E);
    }
    SEAM(8);
    if (IN(9)) {
        constexpr int NCG = DFF / 8;
        const int nitems = NCHUNK * NCG;
        for (int it = vcu * NTHR + tid; it < nitems; it += G * NTHR) {
            const int cg = it % NCG, run = it / NCG, ch = cg * 8;
            const bool smp = run >= MP / 16; const int row0 = smp ? MP + (run - MP / 16) * DSEQ : run * 16; const int T = smp ? DSEQ : 16;
            float w0[8], w1[8], w2[8], cb[8];
#pragma unroll
            for (int i = 0; i < 8; ++i) { w0[i] = fconv_w[ch + i]; w1[i] = fconv_w[DFF + ch + i]; w2[i] = fconv_w[2 * DFF + ch + i]; cb[i] = fconv_b[ch + i]; }
            float am2[8], am1[8];
            if (smp) { const float* st = st_cf + (size_t)(run - MP / 16) * 2 * DFF + ch;
#pragma unroll
                for (int i = 0; i < 8; ++i) { am2[i] = st[i]; am1[i] = st[DFF + i]; }
            } else if ((run & 127) == 0) {
#pragma unroll
                for (int i = 0; i < 8; ++i) { am2[i] = 0.f; am1[i] = 0.f; }
            } else { const v4u a = *(const v4u*)(AB + (size_t)(row0 - 2) * DFF + ch), b = *(const v4u*)(AB + (size_t)(row0 - 1) * DFF + ch);
                am2[0] = bflo(a.x); am2[1] = bfhi(a.x); am2[2] = bflo(a.y); am2[3] = bfhi(a.y); am2[4] = bflo(a.z); am2[5] = bfhi(a.z); am2[6] = bflo(a.w); am2[7] = bfhi(a.w);
                am1[0] = bflo(b.x); am1[1] = bfhi(b.x); am1[2] = bflo(b.y); am1[3] = bfhi(b.y); am1[4] = bflo(b.z); am1[5] = bfhi(b.z); am1[6] = bflo(b.w); am1[7] = bfhi(b.w); }
            v4u aar[16], ggr[16];
#pragma unroll
            for (int t = 0; t < 16; ++t) if (t < T) { const size_t ro = (size_t)(row0 + t) * DFF + ch; aar[t] = *(const v4u*)(AB + ro); ggr[t] = *(const v4u*)(GB + ro); }
#pragma unroll
            for (int t = 0; t < 16; ++t) if (t < T) {
                const size_t ro = (size_t)(row0 + t) * DFF + ch;
                const v4u aa = aar[t], gg = ggr[t];
                float a[8], gv[8];
                a[0] = bflo(aa.x); a[1] = bfhi(aa.x); a[2] = bflo(aa.y); a[3] = bfhi(aa.y); a[4] = bflo(aa.z); a[5] = bfhi(aa.z); a[6] = bflo(aa.w); a[7] = bfhi(aa.w);
                gv[0] = bflo(gg.x); gv[1] = bfhi(gg.x); gv[2] = bflo(gg.y); gv[3] = bfhi(gg.y); gv[4] = bflo(gg.z); gv[5] = bfhi(gg.z); gv[6] = bflo(gg.w); gv[7] = bfhi(gg.w);
                float uo[8];
#pragma unroll
                for (int i = 0; i < 8; ++i) { const float cv = cb[i] + w0[i] * am2[i] + w1[i] * am1[i] + w2[i] * a[i];
                    const float z = 0.7978845608028654f * (cv + 0.044715f * cv * cv * cv);
                    const float th = 1.0f - 2.0f * __builtin_amdgcn_rcpf(1.0f + __builtin_amdgcn_exp2f(2.885390081777927f * z));
                    uo[i] = 0.5f * cv * (1.0f + th) * gv[i]; am2[i] = am1[i]; am1[i] = a[i]; }
                v4u w; w.x = cvtpk(uo[0], uo[1]); w.y = cvtpk(uo[2], uo[3]); w.z = cvtpk(uo[4], uo[5]); w.w = cvtpk(uo[6], uo[7]);
                *(v4u*)(GB + ro) = w;
            }
            if (smp || (run & 127) == 127) {
                float* cs = smp ? out + O_CFS + (size_t)(run - MP / 16) * 2 * DFF + ch : out + O_CFP + (size_t)(run >> 7) * 2 * DFF + ch;
#pragma unroll
                for (int i = 0; i < 8; ++i) { cs[i] = am2[i]; cs[DFF + i] = am1[i]; }
            }
        }
    }
    SEAM(9);
    if (IN(10)) for (int rep_ = 0; rep_ < NREP(10); ++rep_) { if (rep_) xcd_barrier(bar);
        pg8::Gemm g{GB, WDOWN_T, MT, DM, DFF}; pg8::StaticOrder S; S.init(MT, DM, G, bx);
        pg8::EpiF32 E{FB, DM};
        pg8::gemm_phase<pg8::EpiF32, pg8::StaticOrder, true, true>(lds + RING_OFF, g, S, E);
    }
    SEAM(10);
    if (IN(11)) {
        for (int m = gw; m < MT; m += NGW) {
            const f32x4* fr_ = (const f32x4*)(FB + (size_t)m * DM) + lane; const int mb = row_mb(m);
            const f32x4* g2 = (const f32x4*)(MOD + (size_t)mb * NADA + 5 * DM) + lane; const f32x4* np = (const f32x4*)n_post2 + lane;
            f32x4 y[4]; float s = 0.f;
#pragma unroll
            for (int j = 0; j < 4; ++j) { y[j] = fr_[64 * j]; s += (y[j].x * y[j].x + y[j].y * y[j].y) + (y[j].z * y[j].z + y[j].w * y[j].w); }
            const float rstd = rsqrtf(wave_sum(s) * (1.f / DM) + EPS);
            f32x4* xo = (f32x4*)(out + O_Y + (size_t)m * DM) + lane;
#pragma unroll
            for (int j = 0; j < 4; ++j) xo[64 * j] = xo[64 * j] + g2[64 * j] * ((y[j] * rstd) * np[64 * j]);
        }
    }
#undef IN
#undef SEAM
}
#undef ws
#undef out
#undef x_p
#undef x_s
#undef c_p
#undef c_s
#undef st_cm
#undef st_gla
#undef st_cf
#undef w_ada
#undef b_ada
#undef n_pre1
#undef n_post1
#undef n_pre2
#undef n_post2
#undef w_in
#undef conv_w
#undef conv_b
#undef w_a2
#undef b_a
#undef gla_norm
#undef w_out
#undef w_up
#undef fconv_w
#undef fconv_b
#undef w_down
#undef ctl
#undef MOD
#undef WIN_T
#undef WOUT_T
#undef WUP_T
#undef WDOWN_T
#undef HB
#undef UA
#undef FA
#undef RG
#undef QK
#undef VB
#undef LR
#undef KT
#undef DEC
#undef SSQ
#undef ORAW
#undef Y1
#undef H2
#undef AB
#undef GB
#undef FB


#ifdef DBG_STOP
__global__ void dbg_fold(const unsigned short* src, size_t n, float* o, size_t n_out) {
    for (size_t i = (size_t)blockIdx.x * blockDim.x + threadIdx.x; i < n_out; i += (size_t)gridDim.x * blockDim.x) {
        unsigned h = 0; for (size_t j = i; j < n; j += n_out) h = h * 31u + src[j];
        o[i] = (float)(h & 0xfffffu) * (1.0f / 1048576.0f);
    }
}
#endif
#ifndef MK_N_LAUNCHES
#define MK_N_LAUNCHES 1
#endif
extern "C" void kernel_launch(void* const* d_in, const int* in_sizes, int n_in, void* d_out, int out_size, void* d_ws, size_t ws_size, hipStream_t stream) {
    static int grid = 0;
    if (grid == 0) {
        if (n_in != 24 || (size_t)out_size != O_END || ws_size < WS_END) { fprintf(stderr, "kernel_launch: unexpected problem (n_in %d out %d ws %zu)\n", n_in, out_size, ws_size); grid = -1; return; }
        int dev = 0, cus = 0;
        if (hipGetDevice(&dev) != hipSuccess || hipDeviceGetAttribute(&cus, hipDeviceAttributeMultiprocessorCount, dev) != hipSuccess) { grid = -1; return; }
        if (hipFuncSetAttribute((const void*)mk_fwd, hipFuncAttributeMaxDynamicSharedMemorySize, LDS_BYTES) != hipSuccess) { fprintf(stderr, "kernel_launch: hipFuncSetAttribute failed\n"); grid = -1; return; }
        int per_cu = 0;
        if (hipOccupancyMaxActiveBlocksPerMultiprocessor(&per_cu, (const void*)mk_fwd, NTHR, LDS_BYTES) != hipSuccess || per_cu < 1) { fprintf(stderr, "kernel_launch: occupancy query says %d\n", per_cu); }
        (void)hipGetLastError();
        grid = cus;
    }
    if (grid < 0) return;
    (void)hipMemsetAsync((char*)d_ws + WS_CTL, 0, CTL_ZERO_BYTES, stream);
    Args a{};
    for (int i = 0; i < 24; ++i) a.in[i] = (const float*)d_in[i];
    a.out = (float*)d_out; a.ws = (unsigned char*)d_ws;
    if (MK_N_LAUNCHES == 1) {
        a.ph_lo = 0; a.ph_hi = N_PHASES;
        void* kargs[] = {&a};
        hipError_t e = hipLaunchCooperativeKernel((const void*)mk_fwd, dim3(grid), dim3(NTHR), kargs, LDS_BYTES, stream);
        if (e != hipSuccess) fprintf(stderr, "kernel_launch: cooperative launch failed: %s\n", hipGetErrorString(e));
    } else {
#ifdef DBG_STOP
        for (int p = 0; p <= DBG_STOP; ++p) { a.ph_lo = p; a.ph_hi = p + 1; hipLaunchKernelGGL(mk_fwd, dim3(grid), dim3(NTHR), LDS_BYTES, stream, a); }
        hipLaunchKernelGGL(dbg_fold, dim3(2048), dim3(256), 0, stream, (const unsigned short*)((const char*)d_ws + DBG_LO * MiB), (size_t)(DBG_HI - DBG_LO) * MiB / 2, (float*)d_out, (size_t)O_END);
#else
        for (int p = 0; p < N_PHASES; ++p) { a.ph_lo = p; a.ph_hi = p + 1; hipLaunchKernelGGL(mk_fwd, dim3(grid), dim3(NTHR), LDS_BYTES, stream, a); }
#endif
    }
}
```
